# Optimizing an MI355X kernel written in HIP

```python
import math
import jax, jax.numpy as jnp
from jax import lax
import numpy as np

D_MODEL = 1024
BATCH = 2
SEQ = 8192
DEPTH = 2

GRID_W = 64
HEAD_DIM = 64
ATTN_WIDTH = D_MODEL // 2
N_ATTN_HEADS = ATTN_WIDTH // HEAD_DIM
N_KV_HEADS = N_ATTN_HEADS // 4
KV_WIDTH = N_KV_HEADS * HEAD_DIM
SSM_WIDTH = D_MODEL // 2
SSM_HEAD_DIM = 64
SSM_HEADS = SSM_WIDTH // SSM_HEAD_DIM
SSM_GROUPS = 2
SSM_STATE = 128
SSM_CHUNK = 128
CONV_K = 5
XBC_WIDTH = SSM_WIDTH + 2 * SSM_GROUPS * SSM_STATE
D_MIX = ATTN_WIDTH + SSM_WIDTH
IN_SPLITS = (ATTN_WIDTH,
             ATTN_WIDTH + KV_WIDTH,
             ATTN_WIDTH + 2 * KV_WIDTH,
             ATTN_WIDTH + 2 * KV_WIDTH + SSM_WIDTH,
             ATTN_WIDTH + 2 * KV_WIDTH + SSM_WIDTH + XBC_WIDTH)
IN_WIDTH = IN_SPLITS[-1] + 2 * SSM_HEADS
Q_BLOCK = 128
ROPE_THETA = 10000.0
ROPE_AXIS_DIM = HEAD_DIM // 2
N_EXPERTS = 32
TOP_K = 4
D_EXPERT = D_MODEL
SWIGLU_LIMIT = 7.0
SWIGLU_ALPHA = 1.702
MOE_BLOCK = 128
EPS = 1e-6

kernel_name = "hymba_ssd_axial_gqa_moe_encoder"


def rms_norm(x, gain):
    xf = x.astype(jnp.float32)
    y = xf * lax.rsqrt(jnp.mean(xf * xf, axis=-1, keepdims=True) + EPS)
    return (y * gain.astype(jnp.float32)).astype(x.dtype)


def axial_rope_tables(seq_len):
    rows = seq_len // GRID_W
    row = jnp.repeat(jnp.arange(rows, dtype=jnp.float32), GRID_W)
    col = jnp.tile(jnp.arange(GRID_W, dtype=jnp.float32), rows)
    inv_freq = ROPE_THETA ** (-jnp.arange(0, ROPE_AXIS_DIM, 2, dtype=jnp.float32) / ROPE_AXIS_DIM)
    ang_r = row[:, None] * inv_freq
    ang_c = col[:, None] * inv_freq
    return jnp.cos(ang_r), jnp.sin(ang_r), jnp.cos(ang_c), jnp.sin(ang_c)


def rope_1d(x, cos, sin):
    x1, x2 = jnp.split(x, 2, axis=-1)
    c = cos[:, None, :].astype(x.dtype)
    s = sin[:, None, :].astype(x.dtype)
    return jnp.concatenate([x1 * c - x2 * s, x2 * c + x1 * s], axis=-1)


def axial_rope(x, tables):
    cr, sr, cc, sc = tables
    return jnp.concatenate([rope_1d(x[..., :ROPE_AXIS_DIM], cr, sr),
                            rope_1d(x[..., ROPE_AXIS_DIM:], cc, sc)], axis=-1)


def block_attention(q, k, v):
    b, l, h, d = q.shape
    g = h // N_KV_HEADS
    nb = l // Q_BLOCK
    scale = 1.0 / math.sqrt(d)
    qb = q.reshape(b, nb, Q_BLOCK, N_KV_HEADS, g, d).transpose(1, 0, 2, 3, 4, 5)

    def one_block(qi):
        s = jnp.einsum('bqkgd,bskd->bkgqs', qi, k).astype(jnp.float32) * scale
        p = jax.nn.softmax(s, axis=-1).astype(v.dtype)
        return jnp.einsum('bkgqs,bskd->bqkgd', p, v)

    o = lax.map(one_block, qb)
    return o.transpose(1, 0, 2, 3, 4, 5).reshape(b, l, h * d)


def ssd_chunked(x, dt, a, bm, cm):
    b, l, h, p = x.shape
    n = bm.shape[-1]
    c = l // SSM_CHUNK
    x = x.reshape(b, c, SSM_CHUNK, h, p)
    dt = dt.reshape(b, c, SSM_CHUNK, h)
    bm = bm.reshape(b, c, SSM_CHUNK, h, n)
    cm = cm.reshape(b, c, SSM_CHUNK, h, n)
    a_cum = jnp.cumsum(jnp.moveaxis(dt * a, 2, -1), axis=-1)
    xdt = x * dt[..., None]
    seg = a_cum[..., :, None] - a_cum[..., None, :]
    tri = jnp.tril(jnp.ones((SSM_CHUNK, SSM_CHUNK), dtype=bool))
    decay = jnp.exp(jnp.where(tri, seg, -jnp.inf))
    cb = jnp.einsum('bcqhn,bcshn->bchqs', cm, bm)
    y_diag = jnp.einsum('bchqs,bcshp->bcqhp', cb * decay, xdt)
    decay_to_end = jnp.exp(a_cum[..., -1:] - a_cum)
    states = jnp.einsum('bcshn,bchs,bcshp->bchpn', bm, decay_to_end, xdt)
    chunk_decay = jnp.exp(a_cum[..., -1])

    def step(carry, inp):
        st, dec = inp
        return carry * dec[..., None, None] + st, carry

    init = jnp.zeros((b, h, p, n), jnp.float32)
    _, prev = lax.scan(step, init, (jnp.moveaxis(states, 1, 0), jnp.moveaxis(chunk_decay, 1, 0)))
    prev = jnp.moveaxis(prev, 0, 1)
    y_off = jnp.einsum('bcqhn,bchpn,bchq->bcqhp', cm, prev, jnp.exp(a_cum))
    return (y_diag + y_off).reshape(b, l, h, p)


def ssm_branch(z, xbc, dt_raw, conv_w, conv_b, dt_bias, a_log, d_skip, norm_gain):
    b, l, _ = xbc.shape
    f32 = jnp.float32
    xbc = lax.conv_general_dilated(xbc, conv_w[:, None, :].astype(xbc.dtype), window_strides=(1,),
                                   padding=[(CONV_K // 2, CONV_K // 2)],
                                   dimension_numbers=('NWC', 'WIO', 'NWC'),
                                   feature_group_count=XBC_WIDTH) + conv_b
    xbc = jax.nn.silu(xbc)
    xs, bm, cm = jnp.split(xbc, [SSM_WIDTH, SSM_WIDTH + SSM_GROUPS * SSM_STATE], axis=-1)
    rep = SSM_HEADS // SSM_GROUPS
    xs = xs.reshape(b, l, SSM_HEADS, SSM_HEAD_DIM).astype(f32)
    bm = jnp.repeat(bm.reshape(b, l, SSM_GROUPS, SSM_STATE).astype(f32), rep, axis=2)
    cm = jnp.repeat(cm.reshape(b, l, SSM_GROUPS, SSM_STATE).astype(f32), rep, axis=2)
    dt = jax.nn.softplus(dt_raw.astype(f32).reshape(b, l, 2, SSM_HEADS) + dt_bias.astype(f32))
    a = -jnp.exp(a_log.astype(f32))
    y_fwd = ssd_chunked(xs, dt[:, :, 0], a[0], bm, cm)
    flip = lambda t: jnp.flip(t, axis=1)
    y_bwd = flip(ssd_chunked(flip(xs), flip(dt[:, :, 1]), a[1], flip(bm), flip(cm)))
    y = y_fwd + y_bwd + xs * d_skip.astype(f32)[:, None]
    y = y.reshape(b, l, SSM_WIDTH) * jax.nn.silu(z.astype(f32))
    y = rms_norm(y.reshape(b, l, SSM_GROUPS, SSM_WIDTH // SSM_GROUPS),
                 norm_gain.reshape(SSM_GROUPS, SSM_WIDTH // SSM_GROUPS))
    return y.reshape(b, l, SSM_WIDTH).astype(z.dtype)


def moe_ffn(h, w_router, b_router, w_gate, b_gate, w_up, b_up, w_down, b_down):
    b, l, d = h.shape
    t = h.reshape(-1, d)
    n_tok = t.shape[0]
    logits = (t @ w_router + b_router).astype(jnp.float32)
    top_val, top_idx = lax.top_k(logits, TOP_K)
    top_w = jax.nn.softmax(top_val, axis=-1)
    n_assign = n_tok * TOP_K
    flat_e = top_idx.reshape(-1)
    flat_tok = jnp.repeat(jnp.arange(n_tok, dtype=jnp.int32), TOP_K)
    flat_w = top_w.reshape(-1)
    counts = jnp.bincount(flat_e, length=N_EXPERTS)
    padded = (counts + MOE_BLOCK - 1) // MOE_BLOCK * MOE_BLOCK
    pad_end = jnp.cumsum(padded)
    pad_start = pad_end - padded
    start = jnp.cumsum(counts) - counts
    order = jnp.argsort(flat_e)
    sorted_e = flat_e[order]
    dest = pad_start[sorted_e] + jnp.arange(n_assign) - start[sorted_e]
    n_rows = n_assign + N_EXPERTS * MOE_BLOCK
    row_tok = jnp.zeros((n_rows,), jnp.int32).at[dest].set(flat_tok[order])
    row_w = jnp.zeros((n_rows,), jnp.float32).at[dest].set(flat_w[order])
    n_blocks = n_rows // MOE_BLOCK
    block_e = jnp.minimum(jnp.searchsorted(pad_end, jnp.arange(n_blocks) * MOE_BLOCK, side='right'),
                          N_EXPERTS - 1)
    xs = t[row_tok].reshape(n_blocks, MOE_BLOCK, d)

    def expert_block(args):
        xb, e = args
        g = xb @ w_gate[e] + b_gate[e]
        u = xb @ w_up[e] + b_up[e]
        g = jnp.minimum(g, SWIGLU_LIMIT)
        u = jnp.clip(u, -SWIGLU_LIMIT, SWIGLU_LIMIT)
        act = g * jax.nn.sigmoid(SWIGLU_ALPHA * g) * (u + 1.0)
        return act @ w_down[e] + b_down[e]

    ys = lax.map(expert_block, (xs, block_e)).reshape(n_rows, d)
    out = jnp.zeros_like(t).at[row_tok].add(ys * row_w[:, None].astype(t.dtype))
    return out.reshape(b, l, d)


def setup_inputs(seed: int = 0) -> dict:
    key = jax.random.key(seed)
    ks = jax.random.split(key, 24)
    f32 = jnp.float32
    nrm = lambda k, shape, s: jax.random.normal(k, shape, f32) * s
    gain = lambda k, shape: 1.0 + 0.02 * jax.random.normal(k, shape, f32)
    dt0 = jnp.exp(jax.random.uniform(ks[7], (DEPTH, 2, SSM_HEADS), f32) * (math.log(0.1) - math.log(0.001)) + math.log(0.001))
    return {
        "x": nrm(ks[0], (BATCH, SEQ, D_MODEL), 1.0),
        "norm_mix": gain(ks[1], (DEPTH, D_MODEL)),
        "w_in": nrm(ks[2], (DEPTH, D_MODEL, IN_WIDTH), D_MODEL ** -0.5),
        "q_norm": gain(ks[3], (DEPTH, HEAD_DIM)),
        "k_norm": gain(ks[4], (DEPTH, HEAD_DIM)),
        "conv_w": nrm(ks[5], (DEPTH, CONV_K, XBC_WIDTH), CONV_K ** -0.5),
        "conv_b": nrm(ks[6], (DEPTH, XBC_WIDTH), 0.02),
        "dt_bias": dt0 + jnp.log(-jnp.expm1(-dt0)),
        "a_log": jnp.log(jax.random.uniform(ks[8], (DEPTH, 2, SSM_HEADS), f32, 1.0, 16.0)),
        "d_skip": gain(ks[9], (DEPTH, SSM_HEADS)),
        "ssm_norm": gain(ks[10], (DEPTH, SSM_WIDTH)),
        "attn_norm": gain(ks[11], (DEPTH, ATTN_WIDTH)),
        "w_out": nrm(ks[12], (DEPTH, D_MIX, D_MODEL), D_MIX ** -0.5),
        "norm_ffn": gain(ks[13], (DEPTH, D_MODEL)),
        "w_router": nrm(ks[14], (DEPTH, D_MODEL, N_EXPERTS), D_MODEL ** -0.5),
        "b_router": nrm(ks[15], (DEPTH, N_EXPERTS), 0.01),
        "w_gate": nrm(ks[16], (DEPTH, N_EXPERTS, D_MODEL, D_EXPERT), D_MODEL ** -0.5),
        "b_gate": nrm(ks[17], (DEPTH, N_EXPERTS, D_EXPERT), 0.01),
        "w_up": nrm(ks[18], (DEPTH, N_EXPERTS, D_MODEL, D_EXPERT), D_MODEL ** -0.5),
        "b_up": nrm(ks[19], (DEPTH, N_EXPERTS, D_EXPERT), 0.01),
        "w_down": nrm(ks[20], (DEPTH, N_EXPERTS, D_EXPERT, D_MODEL), D_EXPERT ** -0.5),
        "b_down": nrm(ks[21], (DEPTH, N_EXPERTS, D_MODEL), 0.01),
    }


def reference(x, norm_mix, w_in, q_norm, k_norm, conv_w, conv_b, dt_bias, a_log, d_skip,
              ssm_norm, attn_norm, w_out, norm_ffn, w_router, b_router, w_gate, b_gate,
              w_up, b_up, w_down, b_down):
    b, l, _ = x.shape
    rope = axial_rope_tables(l)
    for i in range(DEPTH):
        hn = rms_norm(x, norm_mix[i])
        proj = hn @ w_in[i]
        q, k, v, z, xbc, dt_raw = jnp.split(proj, IN_SPLITS, axis=-1)
        q = axial_rope(rms_norm(q.reshape(b, l, N_ATTN_HEADS, HEAD_DIM), q_norm[i]), rope)
        k = axial_rope(rms_norm(k.reshape(b, l, N_KV_HEADS, HEAD_DIM), k_norm[i]), rope)
        v = v.reshape(b, l, N_KV_HEADS, HEAD_DIM)
        attn = rms_norm(block_attention(q, k, v), attn_norm[i])
        ssm = ssm_branch(z, xbc, dt_raw, conv_w[i], conv_b[i], dt_bias[i], a_log[i],
                         d_skip[i], ssm_norm[i])
        x = x + jnp.concatenate([attn, ssm], axis=-1) @ w_out[i]
        x = x + moe_ffn(rms_norm(x, norm_ffn[i]), w_router[i], b_router[i], w_gate[i], b_gate[i],
                        w_up[i], b_up[i], w_down[i], b_down[i])
    return x
```

```cpp
#include <hip/hip_runtime.h>
#include <cstdint>
#include <cstdio>

typedef unsigned short bf16_t;
typedef short bf16x8 __attribute__((ext_vector_type(8)));
typedef float f32x4 __attribute__((ext_vector_type(4)));
typedef unsigned u32x4 __attribute__((ext_vector_type(4)));
typedef unsigned u32x2 __attribute__((ext_vector_type(2)));

constexpr int D = 1024, BATCH = 2, SEQ = 8192, M = BATCH * SEQ, DEPTH = 2;
constexpr int NPROJ = 2320, NPROJ_PAD = 2560;
constexpr int C_Q = 0, C_K = 512, C_V = 640, C_Z = 768, C_XBC = 1280, C_DT = 2304;
constexpr int NH = 8, NKV = 2, HD = 64;
constexpr int SH = 8, SP = 64, SN = 128, SG = 2, CHUNK = 128, NCHUNK = SEQ / CHUNK;
constexpr int NE = 32, TOPK = 4, DE = 1024;
constexpr int ACT_ROWS = M * TOPK + NE * 256;
constexpr float EPS = 1e-6f;
constexpr float C2 = 0.125f * 1.4426950408889634f;

constexpr size_t MiB = 1u << 20;
constexpr size_t WS_CTL = 0;
constexpr size_t CTL_BYTES = 1 * MiB;
constexpr size_t WS_WIN = 1 * MiB;
constexpr size_t WS_WOUT = WS_WIN + 10 * MiB;
constexpr size_t WS_WGU = WS_WOUT + 4 * MiB;
constexpr size_t WS_WD = WS_WGU + 256 * MiB;
constexpr size_t WS_HN = WS_WD + 128 * MiB;
constexpr size_t WS_PROJ = WS_HN + 32 * MiB;
constexpr size_t WS_XBC = WS_PROJ + 80 * MiB;
constexpr size_t WS_DT = WS_XBC + 32 * MiB;
constexpr size_t WS_MIX = WS_DT + 1 * MiB;
constexpr size_t WS_STF = WS_MIX + 32 * MiB;
constexpr size_t WS_STB = WS_STF + 32 * MiB;
constexpr size_t WS_YTMP = WS_STB + 32 * MiB;
constexpr size_t WS_ACT = WS_YTMP + 32 * MiB;
constexpr size_t WS_YS = WS_ACT + 144 * MiB;
constexpr size_t WS_TKE = WS_YS + 144 * MiB;
constexpr size_t WS_TKW = WS_TKE + 256 * 1024;
constexpr size_t WS_TKR = WS_TKW + 256 * 1024;
constexpr size_t WS_SEG = WS_TKR + 256 * 1024;
constexpr size_t WS_DEC = WS_SEG + 2 * MiB;
constexpr size_t WS_ROPE = WS_DEC + 64 * 1024;
constexpr size_t WS_WRH = WS_ROPE + 64 * 1024;
constexpr size_t WS_WRL = WS_WRH + 128 * 1024;
constexpr size_t WS_SA = WS_WRL + 128 * 1024;
constexpr size_t WS_SM = WS_SA + 64 * 1024;
constexpr size_t WS_SSQ = WS_SM + 64 * 1024;
constexpr size_t WS_END = WS_SSQ + 512 * 1024;
constexpr size_t WS_XR = WS_YS + 80 * MiB;
constexpr size_t WS_MIXQ = WS_XBC;
constexpr size_t WS_PRVF = WS_YTMP, WS_PRVB = WS_YTMP + 16 * MiB;
constexpr int CW_CNT = 1024;
constexpr size_t WS_QKMAX = WS_DEC + 16 * 1024;
constexpr int CW_CMAX_IN = 232000, CW_CMAX_OUT = CW_CMAX_IN + DEPTH * NPROJ_PAD;


__device__ __forceinline__ unsigned f2bf(float f) { unsigned u = __float_as_uint(f); return (u + 0x7fffu + ((u >> 16) & 1u)) >> 16; }
__device__ __forceinline__ float bf2f(unsigned b) { return __uint_as_float(b << 16); }
__device__ __forceinline__ unsigned pk2(float lo, float hi) { return f2bf(lo) | (f2bf(hi) << 16); }
__device__ __forceinline__ float wave_sum(float v) {
#pragma unroll
    for (int o = 1; o < 64; o <<= 1) v += __shfl_xor(v, o);
    return v;
}
__device__ __forceinline__ float silu_f(float v) { return v / (1.f + __expf(-v)); }

#ifndef WT_STORES
#define WT_STORES 0
#endif
__device__ __forceinline__ void st16_wt(void* p, u32x4 v) {
#if WT_STORES
    asm volatile("global_store_dwordx4 %0, %1, off sc1\n\ts_nop 1" :: "v"(p), "v"(v) : "memory");
#else
    *(u32x4*)p = v;
#endif
}
#ifndef PROJ_I8
#define PROJ_I8 1
#endif
#ifndef OUT_I8
#define OUT_I8 0
#endif
#ifndef NORM_FOLD
#define NORM_FOLD 1
#endif
#ifndef YS_F8
#define YS_F8 1
#endif
#ifndef MOE_F8
#define MOE_F8 1
#endif
#define GAS __attribute__((address_space(1)))
#define LAS __attribute__((address_space(3)))
typedef GAS unsigned gu32;
#define RLX_AGENT __ATOMIC_RELAXED, __HIP_MEMORY_SCOPE_AGENT
constexpr int NWAVES = 8, WG = NWAVES * 64;
constexpr int RING_OFF = 0, RING_BYTES = 131072;
constexpr int LDSCTL_OFF = RING_BYTES, MISC_OFF = LDSCTL_OFF + 320;
constexpr int LDS_BYTES = 155648;
constexpr int GIDX_OFF = RING_BYTES + 4096, LBIAS_OFF = RING_BYTES + 10240, MAXORD = 12;
constexpr int CW_BAR = 4096;

#define XB_TMO      128
#define XB_XCNT(j)  (256  + 64 * (j))
#define XB_XSUB(j)  (1280 + 64 * (j))
#define XB_XGEN(j)  (2304 + 64 * (j))
#define XB_TOP      3328
#define XB_TOPGEN   3392
#define XCD_BAR_WORDS 3456
#define XB_SPIN_CAP (1u << 18)
__device__ __forceinline__ unsigned xb_ld(unsigned* p)              { return __hip_atomic_load(p, __ATOMIC_RELAXED, __HIP_MEMORY_SCOPE_AGENT); }
__device__ __forceinline__ unsigned xb_add(unsigned* p, unsigned v) { return __hip_atomic_fetch_add(p, v, __ATOMIC_RELAXED, __HIP_MEMORY_SCOPE_AGENT); }
__device__ __forceinline__ unsigned xb_xcc_id() { return (unsigned)__builtin_amdgcn_s_getreg((3 << 11) | 20) & 0xFu; }
#define XB_SPIN(cond, bar) do { unsigned _sp = 0; while (cond) { __builtin_amdgcn_s_sleep(1); \
    if ((++_sp & 255u) == 0u) { if (xb_ld(&(bar)[XB_TMO])) break; if (_sp > XB_SPIN_CAP) { atomicAdd(&(bar)[XB_TMO], 1u); break; } } } } while (0)
struct XcdBarrier { unsigned* bar; unsigned x; volatile LAS unsigned* st; };
__device__ __forceinline__ XcdBarrier xcd_barrier_post(unsigned* bar, volatile LAS unsigned* st) {
    XcdBarrier b; b.bar = bar; b.x = xb_xcc_id(); b.st = st;
    if (threadIdx.x == 0) (void)xb_add(&bar[XB_XCNT(b.x)], 1u);
    return b;
}
__device__ __forceinline__ void xcd_barrier_complete(unsigned* bar, unsigned x, unsigned& nloc, unsigned& nx) {
    const unsigned G = gridDim.x * gridDim.y * gridDim.z;
    unsigned sum, cnt, mine, sp = 0u;
    for (;;) {
        sum = 0u; cnt = 0u; mine = 0u;
#pragma unroll
        for (unsigned j = 0; j < 16; ++j) { const unsigned c = xb_ld(&bar[XB_XCNT(j)]); sum += c; cnt += (c > 0u) ? 1u : 0u; mine = (j == x) ? c : mine; }
        if (sum == G) break;
        __builtin_amdgcn_s_sleep(1);
        if ((++sp & 255u) == 0u) { if (xb_ld(&bar[XB_TMO])) break; if (sp > XB_SPIN_CAP) { atomicAdd(&bar[XB_TMO], 1u); break; } }
    }
    nloc = mine > 0u ? mine : 1u; nx = cnt > 0u ? cnt : 1u;
}
__device__ __forceinline__ void xcd_barrier(const XcdBarrier& b, const int tid) {
    asm volatile("s_waitcnt vmcnt(0)" ::: "memory");
    __syncthreads();
    if (tid == 0) {
        unsigned* bar = b.bar;
        __builtin_amdgcn_s_waitcnt(0);
        unsigned nloc = b.st[0], nx = b.st[1];
        if (nloc == 0u) { xcd_barrier_complete(bar, b.x, nloc, nx); b.st[0] = nloc; b.st[1] = nx; }
        const unsigned old = xb_add(&bar[XB_XSUB(b.x)], 1u);
        const unsigned gen = old / nloc;
        if (old + 1u == (gen + 1u) * nloc) {
            __builtin_amdgcn_fence(__ATOMIC_RELEASE, "agent");
            asm volatile("s_waitcnt vmcnt(0)" ::: "memory");
            const unsigned og = xb_add(&bar[XB_TOP], 1u);
            const unsigned tg = og / nx;
            if (og + 1u == (tg + 1u) * nx) xb_add(&bar[XB_TOPGEN], 1u);
            else XB_SPIN(xb_ld(&bar[XB_TOPGEN]) == tg, bar);
            __builtin_amdgcn_fence(__ATOMIC_ACQUIRE, "agent");
            xb_add(&bar[XB_XGEN(b.x)], 1u);
            asm volatile("s_waitcnt vmcnt(0)" ::: "memory");
        } else {
            XB_SPIN(xb_ld(&bar[XB_XGEN(b.x)]) == gen, bar);
            __builtin_amdgcn_fence(__ATOMIC_ACQUIRE, "agent");
            asm volatile("s_waitcnt vmcnt(0)" ::: "memory");
        }
    }
    __syncthreads();
}

struct Args { const float* in[22]; float* out; unsigned char* ws; int ph_lo, ph_hi, li, pad; };
struct LP {
    const float *xin, *norm_mix, *q_norm, *k_norm, *conv_w, *conv_b, *dt_bias, *a_log, *d_skip, *ssm_norm, *attn_norm, *norm_ffn, *w_router, *b_router, *b_gate, *b_up, *b_down;
    const bf16_t *Win_t, *Wout_t, *Wgu_t, *Wd_t;
    int* cnt;
};
struct WSP {
    bf16_t *HN, *PROJ, *XBC, *MIX, *ACT, *YS; float *DT, *STF, *STB, *YTMP, *DECF, *DECB, *TKW; int *TKE, *TKR, *SEG;
};
__device__ __forceinline__ LP make_lp(const Args& a, int l) {
    LP p; const float* const* in = a.in; unsigned char* ws = a.ws;
    p.xin = l == 0 ? in[0] : a.out; p.norm_mix = in[1] + l * D; p.q_norm = in[3] + l * HD; p.k_norm = in[4] + l * HD; p.conv_w = in[5] + l * 5 * 1024; p.conv_b = in[6] + l * 1024;
    p.dt_bias = in[7] + l * 16; p.a_log = in[8] + l * 16; p.d_skip = in[9] + l * 8; p.ssm_norm = in[10] + l * 512; p.attn_norm = in[11] + l * 512; p.norm_ffn = in[13] + l * D;
    p.w_router = in[14] + (size_t)l * D * NE; p.b_router = in[15] + l * NE; p.b_gate = in[17] + (size_t)l * NE * DE; p.b_up = in[19] + (size_t)l * NE * DE; p.b_down = in[21] + (size_t)l * NE * D;
    p.Win_t = (const bf16_t*)(ws + WS_WIN) + (size_t)l * NPROJ_PAD * D; p.Wout_t = (const bf16_t*)(ws + WS_WOUT) + (size_t)l * D * D;
    p.Wgu_t = (const bf16_t*)(ws + WS_WGU) + (size_t)l * NE * 2048 * D; p.Wd_t = (const bf16_t*)(ws + WS_WD) + (size_t)l * NE * D * DE;
    p.cnt = (int*)(ws + WS_CTL) + CW_CNT + l * NE;
    return p;
}
__device__ __forceinline__ WSP make_wsp(unsigned char* ws) {
    WSP w; w.HN = (bf16_t*)(ws + WS_HN); w.PROJ = (bf16_t*)(ws + WS_PROJ); w.XBC = (bf16_t*)(ws + WS_XBC); w.MIX = (bf16_t*)(ws + WS_MIX); w.ACT = (bf16_t*)(ws + WS_ACT); w.YS = (bf16_t*)(ws + WS_YS);
    w.DT = (float*)(ws + WS_DT); w.STF = (float*)(ws + WS_STF); w.STB = (float*)(ws + WS_STB); w.YTMP = (float*)(ws + WS_YTMP); w.DECF = (float*)(ws + WS_DEC); w.DECB = w.DECF + 1024;
    w.TKE = (int*)(ws + WS_TKE); w.TKW = (float*)(ws + WS_TKW); w.TKR = (int*)(ws + WS_TKR); w.SEG = (int*)(ws + WS_SEG);
    return w;
}

__device__ __forceinline__ void convT_item(const float* __restrict__ W, int K, int N, bf16_t* __restrict__ WT, int mode, LAS float* scr, int item, int lane, const float* rowgain = nullptr, int ngain = 0) {
    const int nblk = (N + 31) / 32, kb = item / nblk, nb = item % nblk, k0 = 64 * kb, n0 = 32 * nb;
#pragma unroll 8
    for (int i = 0; i < 32; ++i) { const int kk = 2 * i + (lane >> 5); const int n = n0 + (lane & 31); const float gk = (rowgain && k0 + kk < ngain) ? rowgain[k0 + kk] : 1.f; scr[kk * 33 + (lane & 31)] = (n < N) ? W[(size_t)(k0 + kk) * N + n] * gk : 0.f; }
    asm volatile("s_waitcnt lgkmcnt(0)" ::: "memory");
    const int c = lane & 7;
#pragma unroll
    for (int j = 0; j < 4; ++j) { const int nl = (lane >> 3) + 8 * j; const int n = n0 + nl; const LAS float* s = scr + (8 * c) * 33 + nl;
        u32x4 o; o.x = pk2(s[0 * 33], s[1 * 33]); o.y = pk2(s[2 * 33], s[3 * 33]); o.z = pk2(s[4 * 33], s[5 * 33]); o.w = pk2(s[6 * 33], s[7 * 33]);
        int drow = n; if (mode == 1) drow = 256 * (n >> 7) + (n & 127); else if (mode == 2) drow = 256 * (n >> 7) + 128 + (n & 127);
        if (n < N) *(u32x4*)(WT + (size_t)drow * K + k0 + 8 * c) = o; }
    asm volatile("s_waitcnt lgkmcnt(0)" ::: "memory");
}
__device__ __forceinline__ void convT_item8(const float* __restrict__ W, int K, int N, unsigned char* __restrict__ WT, int mode, LAS float* scr, int item, int lane) {
    const int nblk = (N + 31) / 32, kb = item / nblk, nb = item % nblk, k0 = 64 * kb, n0 = 32 * nb;
#pragma unroll 8
    for (int i = 0; i < 32; ++i) { const int kk = 2 * i + (lane >> 5); scr[kk * 33 + (lane & 31)] = W[(size_t)(k0 + kk) * N + n0 + (lane & 31)]; }
    asm volatile("s_waitcnt lgkmcnt(0)" ::: "memory");
    const int c = lane & 7;
#pragma unroll
    for (int j = 0; j < 4; ++j) { const int nl = (lane >> 3) + 8 * j; const int n = n0 + nl; const LAS float* s = scr + (8 * c) * 33 + nl;
        u32x2 o; { int v = __builtin_amdgcn_cvt_pk_fp8_f32(256.f * s[0 * 33], 256.f * s[1 * 33], 0, false); v = __builtin_amdgcn_cvt_pk_fp8_f32(256.f * s[2 * 33], 256.f * s[3 * 33], v, true); o.x = (unsigned)v; }
        { int v = __builtin_amdgcn_cvt_pk_fp8_f32(256.f * s[4 * 33], 256.f * s[5 * 33], 0, false); v = __builtin_amdgcn_cvt_pk_fp8_f32(256.f * s[6 * 33], 256.f * s[7 * 33], v, true); o.y = (unsigned)v; }
        int drow = n; if (mode == 1) drow = 256 * (n >> 7) + (n & 127); else if (mode == 2) drow = 256 * (n >> 7) + 128 + (n & 127);
        *(u32x2*)(WT + (size_t)drow * K + k0 + 8 * c) = o; }
    asm volatile("s_waitcnt lgkmcnt(0)" ::: "memory");
}
__device__ __forceinline__ void ph_convert_experts8(const __attribute__((address_space(4))) Args* a, LAS unsigned char* lds, int bx, int G, const int tid, const int probe = 0) {
    LAS float* scr = (LAS float*)lds;
    unsigned char* ws = a->ws;
    constexpr int NT = 3 * DEPTH * NE * 64;
    f32x4 rgA[8], rgB[8];
#define CV_SRC(T) ((((T) >> 12) == 0 ? a->in[16] : ((T) >> 12) == 1 ? a->in[18] : a->in[20]) + (size_t)(((T) & 4095) >> 6) * D * DE + (size_t)(((((T) & 4095) >> 3) & 7) * 128) * 1024 + ((T) & 7) * 128)
#define CV_LOAD(rg, T) do { if ((T) < NT) { const float* sp_ = CV_SRC(T); _Pragma("unroll") for (int i = 0; i < 8; ++i) { const int id = tid + i * 512; rg[i] = *(const f32x4*)(sp_ + (size_t)(id >> 5) * 1024 + (id & 31) * 4); } } } while (0)
#define CV_TILE(rg, T) do { \
        _Pragma("unroll") for (int i = 0; i < 8; ++i) { const int id = tid + i * 512, k_ = id >> 5; *(LAS f32x4*)(scr + k_ * 132 + (((id & 31) * 4) ^ ((k_ >> 4) << 3))) = rg[i]; } \
        __syncthreads(); \
        CV_LOAD(rg, (T) + 2 * G); \
        { const int kind = (T) >> 12, rem = (T) & 4095, le = rem >> 6, kt = (rem >> 3) & 7, nt_ = rem & 7; const int kc = tid & 7; \
          _Pragma("unroll") for (int ps = 0; ps < 2; ++ps) { const int n = (tid >> 3) + 64 * ps; \
            unsigned char* dst = kind == 2 ? ws + WS_WD + (size_t)le * D * DE + (size_t)(nt_ * 128 + n) * 1024 : ws + WS_WGU + (size_t)le * 2048 * D + (size_t)(256 * nt_ + (kind == 1 ? 128 : 0) + n) * 1024; \
            dst += kt * 128 + kc * 16; unsigned w[4]; const LAS float* sp = scr + (16 * kc) * 132 + (n ^ (kc << 3)); \
            _Pragma("unroll") for (int j = 0; j < 4; ++j) { \
                int v = __builtin_amdgcn_cvt_pk_fp8_f32(256.f * sp[(4 * j) * 132], 256.f * sp[(4 * j + 1) * 132], 0, false); v = __builtin_amdgcn_cvt_pk_fp8_f32(256.f * sp[(4 * j + 2) * 132], 256.f * sp[(4 * j + 3) * 132], v, true); w[j] = (unsigned)v; } \
            if (!(probe & 1)) { *(u32x4*)dst = (u32x4){w[0], w[1], w[2], w[3]}; } else { asm volatile("" :: "v"(w[0]), "v"(w[1]), "v"(w[2]), "v"(w[3])); } } } \
        __syncthreads(); } while (0)
    int T = bx;
    CV_LOAD(rgA, T); CV_LOAD(rgB, T + G);
    for (; T < NT; T += 2 * G) {
        CV_TILE(rgA, T);
        if (T + G < NT) CV_TILE(rgB, T + G);
    }
#undef CV_SRC
#undef CV_LOAD
#undef CV_TILE
}
__device__ __forceinline__ void ph_convert(const __attribute__((address_space(4))) Args* a, LAS unsigned char* lds, int gw, int nw, int wave, int lane) {
    LAS float* scr = (LAS float*)(lds + wave * 16384);
    unsigned char* ws = a->ws;
    bf16_t* Win_t = (bf16_t*)(ws + WS_WIN); bf16_t* Wout_t = (bf16_t*)(ws + WS_WOUT); bf16_t* Wgu_t = (bf16_t*)(ws + WS_WGU); bf16_t* Wd_t = (bf16_t*)(ws + WS_WD);
    constexpr int I_IN = (D / 64) * ((NPROJ + 31) / 32), I_SQ = (D / 64) * (D / 32);
    constexpr int N_IN = DEPTH * I_IN, N_OUT = DEPTH * I_SQ, N_EXP = DEPTH * NE * I_SQ;
    constexpr int NITEMS = N_IN + N_OUT + (MOE_F8 ? 0 : 3 * N_EXP);
    for (int it = (PROJ_I8 ? gw + N_IN : gw); it < NITEMS; it += nw) {
        int r = it;
        if (r < N_IN) { const int l = r / I_IN; convT_item(a->in[2] + (size_t)l * D * NPROJ, D, NPROJ, Win_t + (size_t)l * NPROJ_PAD * D, 0, scr, r % I_IN, lane); continue; } r -= N_IN;
        if (r < N_OUT) { const int l = r / I_SQ; convT_item(a->in[12] + (size_t)l * D * D, D, D, Wout_t + (size_t)l * D * D, 0, scr, r % I_SQ, lane, NORM_FOLD ? a->in[11] + l * 512 : (const float*)nullptr, 512); continue; } r -= N_OUT;
#if MOE_F8
#else
        if (r < N_EXP) { const int le = r / I_SQ; convT_item(a->in[16] + (size_t)le * D * DE, D, DE, Wgu_t + (size_t)le * 2048 * D, 1, scr, r % I_SQ, lane); continue; } r -= N_EXP;
        if (r < N_EXP) { const int le = r / I_SQ; convT_item(a->in[18] + (size_t)le * D * DE, D, DE, Wgu_t + (size_t)le * 2048 * D, 2, scr, r % I_SQ, lane); continue; } r -= N_EXP;
        { const int le = r / I_SQ; convT_item(a->in[20] + (size_t)le * DE * D, DE, D, Wd_t + (size_t)le * D * DE, 0, scr, r % I_SQ, lane); }
#endif
    }
    const int gt = gw * 64 + lane, nt = nw * 64;
    for (int i = (PROJ_I8 ? 1 << 30 : gt); i < DEPTH * (NPROJ_PAD - NPROJ) * D / 8; i += nt) { const int l = i / ((NPROJ_PAD - NPROJ) * D / 8), o = i % ((NPROJ_PAD - NPROJ) * D / 8);
        *(u32x4*)(Win_t + (size_t)l * NPROJ_PAD * D + (size_t)NPROJ * D + (size_t)o * 8) = (u32x4){0u, 0u, 0u, 0u}; }
}
__device__ __forceinline__ float wave_max(float v) {
#pragma unroll
    for (int o = 1; o < 64; o <<= 1) v = fmaxf(v, __shfl_xor(v, o));
    return v;
}
__device__ __forceinline__ unsigned q4_i8(float a, float b, float c, float d, float inv) {
    const int q0 = (int)rintf(a * inv), q1 = (int)rintf(b * inv), q2 = (int)rintf(c * inv), q3 = (int)rintf(d * inv);
    return (unsigned)(q0 & 255) | ((unsigned)(q1 & 255) << 8) | ((unsigned)(q2 & 255) << 16) | ((unsigned)(q3 & 255) << 24);
}
__device__ __forceinline__ void ph_colmax(const float* w_in, const float* w_out, unsigned* cmax_in, unsigned* cmax_out, int gt, int nt) {
    constexpr int I_IN = DEPTH * 16 * NPROJ, I_OUT = DEPTH * 16 * D;
    for (int i = gt; i < I_IN + I_OUT; i += nt) {
        const bool isin = i < I_IN; const int r = isin ? i : i - I_IN, N = isin ? NPROJ : D; const int l = r / (16 * N), r2 = r % (16 * N), kb = r2 / N, n = r2 % N;
        const float* p = (isin ? w_in : w_out) + ((size_t)l * D + kb * 64) * N + n; float m = 0.f;
#pragma unroll 8
        for (int k = 0; k < 64; ++k) m = fmaxf(m, fabsf(p[(size_t)k * N]));
        atomicMax((isin ? cmax_in + l * NPROJ_PAD : cmax_out + l * D) + n, __float_as_uint(m));
    }
}
__device__ __forceinline__ void ph_quant_win_fused(const float* w_in, unsigned char* win8, unsigned* cmax_in, LAS unsigned char* lds, int bx, int G, const int tid) {
    constexpr int NB = (NPROJ + 31) / 32, TP = 1040;
    LAS float* red = (LAS float*)lds; LAS float* cm = (LAS float*)(lds + 8192); LAS unsigned char* T = lds + 8448;
    const int c4 = tid & 7, rg = tid >> 3, lane = tid & 63, wave = tid >> 6;
    __syncthreads();
    for (int it = bx; it < DEPTH * NB; it += G) { const int l = it / NB, n0 = 32 * (it % NB);
        const float* W = w_in + (size_t)l * D * NPROJ; const bool ok = n0 + 4 * c4 < NPROJ;
        f32x4 v[16]; float mx[4] = {0.f, 0.f, 0.f, 0.f};
#pragma unroll
        for (int i = 0; i < 16; ++i) { v[i] = ok ? *(const f32x4*)(W + (size_t)(rg + 64 * i) * NPROJ + n0 + 4 * c4) : (f32x4){0.f, 0.f, 0.f, 0.f};
#pragma unroll
            for (int j = 0; j < 4; ++j) mx[j] = fmaxf(mx[j], fabsf(v[i][j])); }
        *(LAS f32x4*)(red + rg * 32 + 4 * c4) = (f32x4){mx[0], mx[1], mx[2], mx[3]};
        __syncthreads();
        if (tid < 32) { float m = 0.f;
#pragma unroll 8
            for (int r = 0; r < 64; ++r) m = fmaxf(m, red[r * 32 + tid]);
            cm[tid] = m; if (n0 + tid < NPROJ) cmax_in[l * NPROJ_PAD + n0 + tid] = __float_as_uint(m); }
        __syncthreads();
        float inv[4];
#pragma unroll
        for (int j = 0; j < 4; ++j) { const float m = cm[4 * c4 + j]; inv[j] = m > 0.f ? 127.f / m : 0.f; }
#pragma unroll
        for (int i = 0; i < 16; ++i)
#pragma unroll
            for (int j = 0; j < 4; ++j) T[(4 * c4 + j) * TP + rg + 64 * i] = (unsigned char)((int)rintf(v[i][j] * inv[j]) & 255);
        __syncthreads();
#pragma unroll
        for (int r = 0; r < 4; ++r) { const int n = wave + 8 * r; if (n0 + n < NPROJ) *(u32x4*)(win8 + ((size_t)l * NPROJ_PAD + n0 + n) * D + lane * 16) = *(const LAS u32x4*)(T + n * TP + lane * 16); }
        __syncthreads();
    }
    const int gt = bx * 512 + tid, nt = G * 512;
    for (int i = gt; i < DEPTH * (NPROJ_PAD - NPROJ) * D / 16; i += nt) { const int l = i / ((NPROJ_PAD - NPROJ) * D / 16), o = i % ((NPROJ_PAD - NPROJ) * D / 16);
        *(u32x4*)(win8 + (size_t)l * NPROJ_PAD * D + (size_t)NPROJ * D + (size_t)o * 16) = (u32x4){0u, 0u, 0u, 0u}; }
}
__device__ __forceinline__ void convT_item_i8(const float* __restrict__ W, int K, int N, unsigned char* __restrict__ WT, const unsigned* cmax, LAS float* scr, int item, int lane) {
    const int nblk = (N + 31) / 32, kb = item / nblk, nb = item % nblk, k0 = 64 * kb, n0 = 32 * nb;
#pragma unroll 8
    for (int i = 0; i < 32; ++i) { const int kk = 2 * i + (lane >> 5); const int n = n0 + (lane & 31); scr[kk * 33 + (lane & 31)] = (n < N) ? W[(size_t)(k0 + kk) * N + n] : 0.f; }
    asm volatile("s_waitcnt lgkmcnt(0)" ::: "memory");
    const int c = lane & 7;
#pragma unroll
    for (int j = 0; j < 4; ++j) { const int nl = (lane >> 3) + 8 * j; const int n = n0 + nl; const LAS float* s = scr + (8 * c) * 33 + nl;
        if (n < N) { const float mx = __uint_as_float(cmax[n]); const float inv = mx > 0.f ? 127.f / mx : 0.f;
            u32x2 o; o.x = q4_i8(s[0 * 33], s[1 * 33], s[2 * 33], s[3 * 33], inv); o.y = q4_i8(s[4 * 33], s[5 * 33], s[6 * 33], s[7 * 33], inv);
            *(u32x2*)(WT + (size_t)n * K + k0 + 8 * c) = o; } }
    asm volatile("s_waitcnt lgkmcnt(0)" ::: "memory");
}
__device__ __forceinline__ void ph_quant_weights(const float* w_in, const float* w_out, unsigned char* win8, unsigned char* wout8, const unsigned* cmax_in, const unsigned* cmax_out, LAS unsigned char* lds,
                                                 int gw, int nw, int wave, int lane) {
    LAS float* scr = (LAS float*)(lds + wave * 16384);
    constexpr int I_IN = (D / 64) * ((NPROJ + 31) / 32), I_SQ = (D / 64) * (D / 32);
    for (int it = gw; it < DEPTH * (I_IN + (OUT_I8 ? I_SQ : 0)); it += nw) {
        if (it < DEPTH * I_IN) { const int l = it / I_IN; convT_item_i8(w_in + (size_t)l * D * NPROJ, D, NPROJ, win8 + (size_t)l * NPROJ_PAD * D, cmax_in + l * NPROJ_PAD, scr, it % I_IN, lane); }
        else { const int r = it - DEPTH * I_IN, l = r / I_SQ; convT_item_i8(w_out + (size_t)l * D * D, D, D, wout8 + (size_t)l * D * D, cmax_out + l * D, scr, r % I_SQ, lane); }
    }
    const int gt = gw * 64 + lane, nt = nw * 64;
    for (int i = gt; i < DEPTH * (NPROJ_PAD - NPROJ) * D / 16; i += nt) { const int l = i / ((NPROJ_PAD - NPROJ) * D / 16), o = i % ((NPROJ_PAD - NPROJ) * D / 16);
        *(u32x4*)(win8 + (size_t)l * NPROJ_PAD * D + (size_t)NPROJ * D + (size_t)o * 16) = (u32x4){0u, 0u, 0u, 0u}; }
}
__device__ __forceinline__ void ph_rmsnorm_i8(const float* __restrict__ x, const float* __restrict__ gain, unsigned char* __restrict__ outq, float* __restrict__ sA, int gw, int nw, int lane) {
    for (int m = gw; m < M; m += nw) {
        const f32x4* xr = (const f32x4*)(x + (size_t)m * D) + lane; f32x4 v[4]; float s = 0.f;
#pragma unroll
        for (int j = 0; j < 4; ++j) { v[j] = xr[64 * j]; s += v[j].x * v[j].x + v[j].y * v[j].y + v[j].z * v[j].z + v[j].w * v[j].w; }
        const float rstd = 1.0f / sqrtf(wave_sum(s) * (1.f / D) + EPS); float mx = 0.f;
#pragma unroll
        for (int j = 0; j < 4; ++j) { const f32x4 g = ((const f32x4*)gain)[64 * j + lane]; v[j].x *= rstd * g.x; v[j].y *= rstd * g.y; v[j].z *= rstd * g.z; v[j].w *= rstd * g.w;
            mx = fmaxf(fmaxf(mx, fmaxf(fabsf(v[j].x), fabsf(v[j].y))), fmaxf(fabsf(v[j].z), fabsf(v[j].w))); }
        mx = wave_max(mx); const float inv = mx > 0.f ? 127.f / mx : 0.f;
        unsigned* o = (unsigned*)(outq + (size_t)m * D) + lane;
#pragma unroll
        for (int j = 0; j < 4; ++j) o[64 * j] = q4_i8(v[j].x, v[j].y, v[j].z, v[j].w, inv);
        if (lane == 0) sA[m] = mx * (1.f / 127.f);
    }
}
__device__ __forceinline__ void ph_rmsnorm(const float* __restrict__ x, const float* __restrict__ gain, bf16_t* __restrict__ out, int gw, int nw, int lane) {
    for (int m = gw; m < M; m += nw) {
        const f32x4* xr = (const f32x4*)(x + (size_t)m * D) + lane; f32x4 v[4]; float s = 0.f;
#pragma unroll
        for (int j = 0; j < 4; ++j) { v[j] = xr[64 * j]; s += v[j].x * v[j].x + v[j].y * v[j].y + v[j].z * v[j].z + v[j].w * v[j].w; }
        const float rstd = 1.0f / sqrtf(wave_sum(s) * (1.f / D) + EPS);
        u32x2* o = (u32x2*)(out + (size_t)m * D) + lane;
#pragma unroll
        for (int j = 0; j < 4; ++j) { const f32x4 g = ((const f32x4*)gain)[64 * j + lane]; u32x2 w; w.x = pk2(v[j].x * rstd * g.x, v[j].y * rstd * g.y); w.y = pk2(v[j].z * rstd * g.z, v[j].w * rstd * g.w); o[64 * j] = w; }
    }
}
__device__ __forceinline__ void ph_qkrope(bf16_t* proj, const float* __restrict__ qn, const float* __restrict__ kn, const float* rope, unsigned* qkmax, int gt, int nt) {
    const int gid = gt >> 2, part = gt & 3, half = part >> 1, c = part & 1, ng = nt >> 2;
    constexpr int TR = 5;
    u32x4 ra[TR], rb[TR]; float q2m = 0.f, k2m = 0.f;
#pragma unroll
    for (int it = 0; it < TR; ++it) { const int gh = gid + it * ng; if (gh < M * 10) { const int m = gh / 10, hs = gh % 10;
        const bf16_t* p = proj + (size_t)m * NPROJ_PAD + (hs < 8 ? C_Q + hs * 64 : C_K + (hs - 8) * 64) + half * 32 + c * 8; ra[it] = *(const u32x4*)p; rb[it] = *(const u32x4*)(p + 16); } }
#pragma unroll
    for (int it = 0; it < TR; ++it) { const int gh = gid + it * ng; if (gh >= M * 10) break;
        const int m = gh / 10, hs = gh % 10, t = m & (SEQ - 1);
        bf16_t* p = proj + (size_t)m * NPROJ_PAD + (hs < 8 ? C_Q + hs * 64 : C_K + (hs - 8) * 64) + half * 32 + c * 8;
        const float* gn = (hs < 8 ? qn : kn) + half * 32 + c * 8;
        const unsigned wa[4] = {ra[it].x, ra[it].y, ra[it].z, ra[it].w}, wb[4] = {rb[it].x, rb[it].y, rb[it].z, rb[it].w};
        float a[8], b[8]; float ss = 0.f;
#pragma unroll
        for (int k = 0; k < 4; ++k) { a[2 * k] = bf2f(wa[k] & 0xffffu); a[2 * k + 1] = bf2f(wa[k] >> 16); b[2 * k] = bf2f(wb[k] & 0xffffu); b[2 * k + 1] = bf2f(wb[k] >> 16); }
#pragma unroll
        for (int k = 0; k < 8; ++k) ss += a[k] * a[k] + b[k] * b[k];
        ss += __shfl_xor(ss, 1); ss += __shfl_xor(ss, 2);
        const float rstd = (1.0f / sqrtf(ss * (1.f / 64.f) + EPS)) * (hs < 8 ? C2 : 1.f);
        const float* tb = rope + (half ? (128 + (t & 63)) : (t >> 6)) * 32 + c * 8;
        const f32x4 c0v = *(const f32x4*)tb, c1v = *(const f32x4*)(tb + 4), s0v = *(const f32x4*)(tb + 16), s1v = *(const f32x4*)(tb + 20);
        const f32x4 ga = *(const f32x4*)gn, gb = *(const f32x4*)(gn + 4), gc = *(const f32x4*)(gn + 16), gd = *(const f32x4*)(gn + 20);
        const float csv[8] = {c0v.x, c0v.y, c0v.z, c0v.w, c1v.x, c1v.y, c1v.z, c1v.w}, snv[8] = {s0v.x, s0v.y, s0v.z, s0v.w, s1v.x, s1v.y, s1v.z, s1v.w};
        const float g1[8] = {ga.x, ga.y, ga.z, ga.w, gb.x, gb.y, gb.z, gb.w}, g2[8] = {gc.x, gc.y, gc.z, gc.w, gd.x, gd.y, gd.z, gd.w};
        unsigned oa[4], ob[4];
#pragma unroll
        for (int k = 0; k < 4; ++k) { float r0[2], r1[2];
#pragma unroll
            for (int e = 0; e < 2; ++e) { const int d = 2 * k + e; const float x1 = a[d] * rstd * g1[d], x2 = b[d] * rstd * g2[d], cs = csv[d], sn = snv[d]; r0[e] = x1 * cs - x2 * sn; r1[e] = x2 * cs + x1 * sn; }
            oa[k] = pk2(r0[0], r0[1]); ob[k] = pk2(r1[0], r1[1]); }
        *(u32x4*)p = (u32x4){oa[0], oa[1], oa[2], oa[3]}; *(u32x4*)(p + 16) = (u32x4){ob[0], ob[1], ob[2], ob[3]};
        float s2 = 0.f;
#pragma unroll
        for (int k = 0; k < 4; ++k) { const float x0 = __uint_as_float(oa[k] << 16), x1 = __uint_as_float(oa[k] & 0xffff0000u), y0 = __uint_as_float(ob[k] << 16), y1 = __uint_as_float(ob[k] & 0xffff0000u); s2 += x0 * x0 + x1 * x1 + y0 * y0 + y1 * y1; }
        s2 += __shfl_xor(s2, 1); s2 += __shfl_xor(s2, 2);
        if (hs < 8) q2m = fmaxf(q2m, s2); else k2m = fmaxf(k2m, s2);
    }
#pragma unroll
    for (int o = 4; o < 64; o <<= 1) { q2m = fmaxf(q2m, __shfl_xor(q2m, o)); k2m = fmaxf(k2m, __shfl_xor(k2m, o)); }
    if ((gt & 63) == 0) { qkmax[(gt >> 6) * 2] = __float_as_uint(q2m); qkmax[(gt >> 6) * 2 + 1] = __float_as_uint(k2m); }
}
__device__ __forceinline__ void ph_rope_table(float* rope, int gt, int nt) {
    for (int i = gt; i < 192 * 16; i += nt) { const int r = i >> 4, j = i & 15; const float inv = powf(10000.f, -(float)j / 16.f); const float ang = (float)(r < 128 ? r : r - 128) * inv;
        float sn, cs; sincosf(ang, &sn, &cs); rope[r * 32 + j] = cs; rope[r * 32 + 16 + j] = sn; }
}
__device__ __forceinline__ void ph_conv(const bf16_t* proj, const float* __restrict__ cw, const float* __restrict__ cb, bf16_t* xbc, int gt, int nt) {
    for (int i = gt; i < (M / 8) * 128; i += nt) {
        const int rbk = i >> 7, c0 = (i & 127) * 8, m0 = rbk * 8, t0 = m0 & (SEQ - 1);
        u32x4 raw[12];
#pragma unroll
        for (int r = 0; r < 12; ++r) { const int tt = t0 + r - 2; raw[r] = (tt >= 0 && tt < SEQ) ? *(const u32x4*)(proj + (size_t)(m0 + r - 2) * NPROJ_PAD + C_XBC + c0) : (u32x4){0u, 0u, 0u, 0u}; }
        float w[5][8];
#pragma unroll
        for (int j = 0; j < 5; ++j) { const f32x4 w0 = *(const f32x4*)(cw + j * 1024 + c0), w1 = *(const f32x4*)(cw + j * 1024 + c0 + 4); w[j][0] = w0.x; w[j][1] = w0.y; w[j][2] = w0.z; w[j][3] = w0.w; w[j][4] = w1.x; w[j][5] = w1.y; w[j][6] = w1.z; w[j][7] = w1.w; }
        const f32x4 b0 = *(const f32x4*)(cb + c0), b1 = *(const f32x4*)(cb + c0 + 4); const float bias[8] = {b0.x, b0.y, b0.z, b0.w, b1.x, b1.y, b1.z, b1.w};
#pragma unroll
        for (int r = 0; r < 8; ++r) { float acc[8];
#pragma unroll
            for (int k = 0; k < 8; ++k) acc[k] = bias[k];
#pragma unroll
            for (int j = 0; j < 5; ++j) { const unsigned ww[4] = {raw[r + j].x, raw[r + j].y, raw[r + j].z, raw[r + j].w};
#pragma unroll
                for (int k = 0; k < 4; ++k) { acc[2 * k] += bf2f(ww[k] & 0xffffu) * w[j][2 * k]; acc[2 * k + 1] += bf2f(ww[k] >> 16) * w[j][2 * k + 1]; } }
            u32x4 o; o.x = pk2(silu_f(acc[0]), silu_f(acc[1])); o.y = pk2(silu_f(acc[2]), silu_f(acc[3])); o.z = pk2(silu_f(acc[4]), silu_f(acc[5])); o.w = pk2(silu_f(acc[6]), silu_f(acc[7]));
            *(u32x4*)(xbc + (size_t)(m0 + r) * 1024 + c0) = o; }
    }
}
__device__ __forceinline__ void ph_dt(const bf16_t* __restrict__ proj, const float* __restrict__ dtb, float* __restrict__ dt, int gt, int nt) {
    for (int i = gt; i < M * 16; i += nt) { const int m = i >> 4, c = i & 15;
        const float v = bf2f(proj[(size_t)m * NPROJ_PAD + C_DT + c]) + dtb[c];
        dt[i] = fmaxf(v, 0.f) + __logf(1.f + __expf(-fabsf(v))); }
}
__device__ __forceinline__ void ph_attnnorm(bf16_t* mix, const float* __restrict__ gain, int gw, int nw, int lane) {
    const float* g = gain + lane * 8;
    for (int m0 = gw; m0 < M; m0 += 4 * nw) {
        u32x4 raw[4];
#pragma unroll
        for (int r = 0; r < 4; ++r) raw[r] = *((const u32x4*)(mix + (size_t)(m0 + r * nw) * D) + lane);
#pragma unroll
        for (int r = 0; r < 4; ++r) { const unsigned w[4] = {raw[r].x, raw[r].y, raw[r].z, raw[r].w};
            float v[8]; float s = 0.f;
#pragma unroll
            for (int k = 0; k < 4; ++k) { v[2 * k] = bf2f(w[k] & 0xffffu); v[2 * k + 1] = bf2f(w[k] >> 16); s += v[2 * k] * v[2 * k] + v[2 * k + 1] * v[2 * k + 1]; }
            const float rstd = 1.0f / sqrtf(wave_sum(s) * (1.f / 512.f) + EPS);
            u32x4 o; o.x = pk2(v[0] * rstd * g[0], v[1] * rstd * g[1]); o.y = pk2(v[2] * rstd * g[2], v[3] * rstd * g[3]); o.z = pk2(v[4] * rstd * g[4], v[5] * rstd * g[5]); o.w = pk2(v[6] * rstd * g[6], v[7] * rstd * g[7]);
            *((u32x4*)(mix + (size_t)(m0 + r * nw) * D) + lane) = o; }
    }
}
__device__ __forceinline__ void ph_attnnorm_i8(const bf16_t* mix, const float* __restrict__ gain, unsigned char* mixq, float* sM, int gw, int nw, int lane) {
    for (int m = gw; m < M; m += nw) {
        const u32x4 ra = *((const u32x4*)(mix + (size_t)m * D) + lane), rs = *((const u32x4*)(mix + (size_t)m * D + 512) + lane);
        const unsigned wa[4] = {ra.x, ra.y, ra.z, ra.w}, ws_[4] = {rs.x, rs.y, rs.z, rs.w};
        float a[8], b[8]; float s = 0.f;
#pragma unroll
        for (int k = 0; k < 4; ++k) { a[2 * k] = bf2f(wa[k] & 0xffffu); a[2 * k + 1] = bf2f(wa[k] >> 16); b[2 * k] = bf2f(ws_[k] & 0xffffu); b[2 * k + 1] = bf2f(ws_[k] >> 16); s += a[2 * k] * a[2 * k] + a[2 * k + 1] * a[2 * k + 1]; }
        const float rstd = 1.0f / sqrtf(wave_sum(s) * (1.f / 512.f) + EPS);
        const float* g = gain + lane * 8; float mx = 0.f;
#pragma unroll
        for (int k = 0; k < 8; ++k) { a[k] *= rstd * g[k]; mx = fmaxf(mx, fmaxf(fabsf(a[k]), fabsf(b[k]))); }
        mx = wave_max(mx); const float inv = mx > 0.f ? 127.f / mx : 0.f;
        u32x2 qa, qb; qa.x = q4_i8(a[0], a[1], a[2], a[3], inv); qa.y = q4_i8(a[4], a[5], a[6], a[7], inv); qb.x = q4_i8(b[0], b[1], b[2], b[3], inv); qb.y = q4_i8(b[4], b[5], b[6], b[7], inv);
        *((u32x2*)(mixq + (size_t)m * D) + lane) = qa; *((u32x2*)(mixq + (size_t)m * D + 512) + lane) = qb;
        if (lane == 0) sM[m] = mx * (1.f / 127.f);
    }
}
__device__ __forceinline__ void ph_scan(const bf16_t* stf, const bf16_t* stb, bf16_t* prvf, bf16_t* prvb, const float* decf, const float* decb, int gt, int nt) {
    typedef float f32x2 __attribute__((ext_vector_type(2)));
    for (int i = gt; i < 2 * BATCH * SH * 4096; i += nt) {
        const int dir = i >> 16, rest = i & 65535, b = rest >> 15, h = (rest >> 12) & 7, pn = (rest & 4095) * 2;
        const bf16_t* st = dir ? stb : stf; bf16_t* pv = dir ? prvb : prvf; const float* dec = dir ? decb : decf;
        float c0 = 0.f, c1 = 0.f;
#pragma unroll 1
        for (int cb = 0; cb < NCHUNK; cb += 32) {
            unsigned v[32]; float dv[32];
#pragma unroll
            for (int k = 0; k < 32; ++k) { const int c = dir ? (NCHUNK - 1 - cb - k) : (cb + k); const int u = (b * NCHUNK + c) * 8 + h; v[k] = *(const unsigned*)(st + (size_t)u * 8192 + pn); dv[k] = dec[u]; }
#pragma unroll
            for (int k = 0; k < 32; ++k) { const int c = dir ? (NCHUNK - 1 - cb - k) : (cb + k); const int u = (b * NCHUNK + c) * 8 + h;
                *(unsigned*)(pv + (size_t)u * 8192 + pn) = pk2(c0, c1); c0 = c0 * dv[k] + bf2f(v[k] & 0xffffu); c1 = c1 * dv[k] + bf2f(v[k] >> 16); }
        }
    }
}
__device__ __forceinline__ void ph_ssdnorm(const float* __restrict__ ytmp, const float* __restrict__ gain, bf16_t* __restrict__ mix, int gw, int nw, int lane) {
    for (int i = gw; i < M * 2; i += nw) { const int m = i >> 1, g = i & 1;
        const f32x4 v = *((const f32x4*)(ytmp + (size_t)m * 512 + g * 256) + lane);
        const float rstd = 1.0f / sqrtf(wave_sum(v.x * v.x + v.y * v.y + v.z * v.z + v.w * v.w) * (1.f / 256.f) + EPS);
        const f32x4 gn = *((const f32x4*)(gain + g * 256) + lane);
        u32x2 o; o.x = pk2(v.x * rstd * gn.x, v.y * rstd * gn.y); o.y = pk2(v.z * rstd * gn.z, v.w * rstd * gn.w);
        *((u32x2*)(mix + (size_t)m * D + 512 + g * 256) + lane) = o; }
}
__device__ __forceinline__ void ph_router_table(const float* w_router, const float* norm_ffn, bf16_t* wrh, bf16_t* wrl, int gt, int nt) {
    for (int i = gt; i < DEPTH * NE * D; i += nt) { const int l = i / (NE * D), r = i % (NE * D), e = r >> 10, k = r & 1023;
        const float w = norm_ffn[l * D + k] * w_router[((size_t)l * D + k) * NE + e]; const unsigned hi = f2bf(w); const unsigned lo = f2bf(w - bf2f(hi));
        wrh[i] = (bf16_t)hi; wrl[i] = (bf16_t)lo; }
}
__device__ __forceinline__ void ph_router(const bf16_t* x1, const float* __restrict__ gain, const bf16_t* wrh, const bf16_t* wrl, const float* __restrict__ br, bf16_t* hmoe,
                                          int* cnt, int* seg, int* tke, float* tkw, int* tkr, LAS unsigned char* lds, int bx, int G, const int tid, const int skip = 0) {
    const int lane = tid & 63, wave = __builtin_amdgcn_readfirstlane(tid >> 6), g4 = lane >> 4, fr = lane & 15;
    LAS float* part = (LAS float*)lds; LAS float* ssqp = (LAS float*)(lds + 65536); LAS float* lt = (LAS float*)(lds + 67584); LAS float* rstdv = (LAS float*)(lds + 76032);
    for (int rb = bx; rb < M / 64; rb += G) {
        const int k0 = wave * 128 + 8 * g4;
        const bf16_t* xp = x1 + (size_t)(rb * 64 + fr) * D + k0;
        const bf16_t* bhp = wrh + (size_t)fr * D + k0; const bf16_t* blp = wrl + (size_t)fr * D + k0;
        u32x4 xf[4][4];
#pragma unroll
        for (int ks = 0; ks < 4; ++ks)
#pragma unroll
            for (int t = 0; t < 4; ++t) xf[ks][t] = *(const u32x4*)(xp + (size_t)t * 16 * D + 32 * ks);
        f32x4 acc[4][2]; float ss[4];
#pragma unroll
        for (int t = 0; t < 4; ++t) { acc[t][0] = (f32x4){0.f, 0.f, 0.f, 0.f}; acc[t][1] = acc[t][0]; ss[t] = 0.f; }
        if (!(skip & 1)) {
#pragma unroll
        for (int ks = 0; ks < 4; ++ks) {
            const bf16x8 bh0 = *(const bf16x8*)(bhp + 32 * ks), bh1 = *(const bf16x8*)(bhp + 16 * D + 32 * ks), bl0 = *(const bf16x8*)(blp + 32 * ks), bl1 = *(const bf16x8*)(blp + 16 * D + 32 * ks);
#pragma unroll
            for (int t = 0; t < 4; ++t) { const bf16x8 ah = __builtin_bit_cast(bf16x8, xf[ks][t]);
                acc[t][0] = __builtin_amdgcn_mfma_f32_16x16x32_bf16(ah, bh0, acc[t][0], 0, 0, 0); acc[t][0] = __builtin_amdgcn_mfma_f32_16x16x32_bf16(ah, bl0, acc[t][0], 0, 0, 0);
                acc[t][1] = __builtin_amdgcn_mfma_f32_16x16x32_bf16(ah, bh1, acc[t][1], 0, 0, 0); acc[t][1] = __builtin_amdgcn_mfma_f32_16x16x32_bf16(ah, bl1, acc[t][1], 0, 0, 0);
                const unsigned w_[4] = {xf[ks][t].x, xf[ks][t].y, xf[ks][t].z, xf[ks][t].w};
#pragma unroll
                for (int k = 0; k < 4; ++k) { const float a = __uint_as_float(w_[k] << 16), b = __uint_as_float(w_[k] & 0xffff0000u); ss[t] += a * a + b * b; } }
        } }
#pragma unroll
        for (int t = 0; t < 4; ++t) { ss[t] += __shfl_xor(ss[t], 16); ss[t] += __shfl_xor(ss[t], 32);
            LAS float* pp = part + ((wave * 4 + t) * 64 + lane) * 8; *(LAS f32x4*)pp = acc[t][0]; *(LAS f32x4*)(pp + 4) = acc[t][1];
            if (g4 == 0) ssqp[wave * 64 + t * 16 + fr] = ss[t]; }
        __syncthreads();
        {
            const int t = wave & 3, h = wave >> 2; f32x4 a = (f32x4){0.f, 0.f, 0.f, 0.f};
#pragma unroll
            for (int src = 0; src < 8; ++src) a += *(const LAS f32x4*)(part + ((src * 4 + t) * 64 + lane) * 8 + h * 4);
            const float bb = br[16 * h + fr];
#pragma unroll
            for (int j = 0; j < 4; ++j) { const int r = t * 16 + 4 * g4 + j; float sq = 0.f;
#pragma unroll
                for (int src = 0; src < 8; ++src) sq += ssqp[src * 64 + r];
                const float rs = 1.0f / sqrtf(sq * (1.f / D) + EPS);
                lt[r * 33 + 16 * h + fr] = a[j] * rs + bb; if (h == 0 && fr == 0) rstdv[r] = rs; }
        }
        __syncthreads();
        if (tid < 64 && !(skip & 2)) {
            const int m = rb * 64 + tid; float lg[32];
#pragma unroll
            for (int e = 0; e < 32; ++e) lg[e] = lt[tid * 33 + e];
            int ei[4]; float ev[4];
#pragma unroll
            for (int k = 0; k < 4; ++k) { float best = -3.0e38f; int bi = 0;
#pragma unroll
                for (int e = 0; e < 32; ++e) if (lg[e] > best) { best = lg[e]; bi = e; }
                ei[k] = bi; ev[k] = best;
#pragma unroll
                for (int e = 0; e < 32; ++e) if (e == bi) lg[e] = -3.0e38f; }
            const float p1 = __expf(ev[1] - ev[0]), p2 = __expf(ev[2] - ev[0]), p3 = __expf(ev[3] - ev[0]); const float inv = __builtin_amdgcn_rcpf(1.f + p1 + p2 + p3);
            const float wv[4] = {inv, p1 * inv, p2 * inv, p3 * inv};
            LAS int* lcnt = (LAS int*)(lds + 76288); LAS int* lbase = lcnt + 32;
            if (tid < 32) lcnt[tid] = 0;
            asm volatile("s_waitcnt lgkmcnt(0)" ::: "memory");
            int lr[4];
#pragma unroll
            for (int k = 0; k < 4; ++k) lr[k] = __hip_atomic_fetch_add(lcnt + ei[k], 1, __ATOMIC_RELAXED, __HIP_MEMORY_SCOPE_WORKGROUP);
            asm volatile("s_waitcnt lgkmcnt(0)" ::: "memory");
            if (tid < 32) { const int c = lcnt[tid]; lbase[tid] = c > 0 ? atomicAdd(&cnt[tid], c) : 0; }
            asm volatile("s_waitcnt vmcnt(0) lgkmcnt(0)" ::: "memory");
#pragma unroll
            for (int k = 0; k < 4; ++k) { const int e = ei[k]; const int rank = lbase[e] + lr[k]; seg[e * M + rank] = m; tke[m * 4 + k] = e; tkw[m * 4 + k] = wv[k]; tkr[m * 4 + k] = rank; }
        }
        if (!(skip & 4)) {
#pragma unroll
        for (int ks = 0; ks < 4; ++ks) { const float* gp = gain + wave * 128 + 32 * ks + 8 * g4; const f32x4 ga = *(const f32x4*)gp, gb = *(const f32x4*)(gp + 4);
#pragma unroll
            for (int t = 0; t < 4; ++t) { const size_t m = (size_t)rb * 64 + t * 16 + fr; const unsigned w_[4] = {xf[ks][t].x, xf[ks][t].y, xf[ks][t].z, xf[ks][t].w};
                float v[8];
#pragma unroll
                for (int k = 0; k < 4; ++k) { v[2 * k] = __uint_as_float(w_[k] << 16); v[2 * k + 1] = __uint_as_float(w_[k] & 0xffff0000u); }
#if MOE_F8
                const float rs = 16.f * rstdv[t * 16 + fr];
                int w0 = __builtin_amdgcn_cvt_pk_fp8_f32(v[0] * rs * ga.x, v[1] * rs * ga.y, 0, false); w0 = __builtin_amdgcn_cvt_pk_fp8_f32(v[2] * rs * ga.z, v[3] * rs * ga.w, w0, true);
                int w1 = __builtin_amdgcn_cvt_pk_fp8_f32(v[4] * rs * gb.x, v[5] * rs * gb.y, 0, false); w1 = __builtin_amdgcn_cvt_pk_fp8_f32(v[6] * rs * gb.z, v[7] * rs * gb.w, w1, true);
                *(u32x2*)((unsigned char*)hmoe + m * D + wave * 128 + 32 * ks + 8 * g4) = (u32x2){(unsigned)w0, (unsigned)w1};
#else
                const float rs = rstdv[t * 16 + fr];
                *(u32x4*)(hmoe + m * D + wave * 128 + 32 * ks + 8 * g4) = (u32x4){pk2(v[0] * rs * ga.x, v[1] * rs * ga.y), pk2(v[2] * rs * ga.z, v[3] * rs * ga.w), pk2(v[4] * rs * gb.x, v[5] * rs * gb.y), pk2(v[6] * rs * gb.z, v[7] * rs * gb.w)};
#endif
            } } }
        __syncthreads();
    }
}
typedef float f32x2v __attribute__((ext_vector_type(2)));
__device__ __forceinline__ void ph_combine(const bf16_t* xin, bf16_t* xout, float* out, const bf16_t* ys, const int* cnt, const int* tke, const float* tkw, const int* tkr, LAS int* pstart, const float* gain_next, bf16_t* hn, float* sA,
                                           int gw, int nw, int lane, int tid) {
    if (tid == 0) { int ps = 0; for (int e = 0; e < NE; ++e) { pstart[e] = ps; ps += ((cnt[e] + 255) / 256) * 256; } }
    __syncthreads();
    for (int m = gw; m < M; m += nw) {
        const u32x2* xr = (const u32x2*)(xin + (size_t)m * D) + lane; f32x4 acc[4];
#pragma unroll
        for (int j = 0; j < 4; ++j) { const u32x2 r = xr[64 * j]; acc[j] = (f32x4){__uint_as_float(r.x << 16), __uint_as_float(r.x & 0xffff0000u), __uint_as_float(r.y << 16), __uint_as_float(r.y & 0xffff0000u)}; }
#pragma unroll
        for (int k = 0; k < 4; ++k) { const int e = tke[m * 4 + k]; const float w = tkw[m * 4 + k]; const size_t row = (size_t)pstart[e] + tkr[m * 4 + k];
#if YS_F8
            const unsigned* yr = (const unsigned*)((const unsigned char*)ys + row * D) + lane; const float w8 = w * 0.125f;
#pragma unroll
            for (int j = 0; j < 4; ++j) { const int r = (int)yr[64 * j]; const f32x2v lo = __builtin_amdgcn_cvt_pk_f32_fp8(r, false), hi = __builtin_amdgcn_cvt_pk_f32_fp8(r, true);
                acc[j].x += w8 * lo.x; acc[j].y += w8 * lo.y; acc[j].z += w8 * hi.x; acc[j].w += w8 * hi.y; } }
#else
            const u32x2* yr = (const u32x2*)(ys + row * D) + lane;
#pragma unroll
            for (int j = 0; j < 4; ++j) { const u32x2 r = yr[64 * j]; acc[j].x += w * bf2f(r.x & 0xffffu); acc[j].y += w * bf2f(r.x >> 16); acc[j].z += w * bf2f(r.y & 0xffffu); acc[j].w += w * bf2f(r.y >> 16); } }
#endif
        float s = 0.f;
#pragma unroll
        for (int j = 0; j < 4; ++j) { if (xout) { u32x2 w; w.x = pk2(acc[j].x, acc[j].y); w.y = pk2(acc[j].z, acc[j].w); ((u32x2*)(xout + (size_t)m * D) + lane)[64 * j] = w; } else ((f32x4*)(out + (size_t)m * D) + lane)[64 * j] = acc[j];
            s += acc[j].x * acc[j].x + acc[j].y * acc[j].y + acc[j].z * acc[j].z + acc[j].w * acc[j].w; }
        if (gain_next) {
            const float rstd = 1.0f / sqrtf(wave_sum(s) * (1.f / D) + EPS);
#if PROJ_I8
            float mx = 0.f;
#pragma unroll
            for (int j = 0; j < 4; ++j) { const f32x4 g = ((const f32x4*)gain_next)[64 * j + lane]; acc[j].x *= rstd * g.x; acc[j].y *= rstd * g.y; acc[j].z *= rstd * g.z; acc[j].w *= rstd * g.w;
                mx = fmaxf(fmaxf(mx, fmaxf(fabsf(acc[j].x), fabsf(acc[j].y))), fmaxf(fabsf(acc[j].z), fabsf(acc[j].w))); }
            mx = wave_max(mx); const float inv = mx > 0.f ? 127.f / mx : 0.f;
            unsigned* o = (unsigned*)((unsigned char*)hn + (size_t)m * D) + lane;
#pragma unroll
            for (int j = 0; j < 4; ++j) o[64 * j] = q4_i8(acc[j].x, acc[j].y, acc[j].z, acc[j].w, inv);
            if (lane == 0) sA[m] = mx * (1.f / 127.f);
#else
            u32x2* o = (u32x2*)(hn + (size_t)m * D) + lane;
#pragma unroll
            for (int j = 0; j < 4; ++j) { const f32x4 g = ((const f32x4*)gain_next)[64 * j + lane]; u32x2 w; w.x = pk2(acc[j].x * rstd * g.x, acc[j].y * rstd * g.y); w.y = pk2(acc[j].z * rstd * g.z, acc[j].w * rstd * g.w); o[64 * j] = w; }
#endif
        }
    }
    __syncthreads();
}
namespace g8 {
constexpr int BM = 256, BK = 64, HALF = 128, HTB = HALF * BK * 2, STAGE_BYTES = 8 * HTB, NXCD = 8, WGM = 8;
constexpr int GK = 1024;
#ifndef EXPERT_GROUP4
#define EXPERT_GROUP4 0
#endif
#ifndef EXPERT_XCD_ORDER
#define EXPERT_XCD_ORDER 0
#endif
#ifndef F8_SCALE
#define F8_SCALE 0
#endif
__device__ __forceinline__ int lds_byte(int r, int c) { const int st = (r >> 4) * 2 + (c >> 5), rr = r & 15, cc = c & 31, ob = rr * 64 + cc * 2; return st * 1024 + (ob ^ (((ob >> 9) & 1) << 5)); }
__device__ __forceinline__ int lds_byte_b(int r, int cb) { const int st = (r >> 4) * 2 + (cb >> 6), rr = r & 15, ob = rr * 64 + (cb & 63); return st * 1024 + (ob ^ (((ob >> 9) & 1) << 5)); }
typedef int v8i __attribute__((ext_vector_type(8)));
typedef int i32x4 __attribute__((ext_vector_type(4)));
__device__ __forceinline__ void stage_rc(int b, int& R, int& C) { const int st = b / 1024, sb = b % 1024, swz = sb ^ (((sb >> 9) & 1) << 5); R = (st >> 1) * 16 + swz / 64; C = (st & 1) * 32 + (swz % 64) / 2; }
__device__ __forceinline__ int perm32(int rho) { const int n = rho >> 4, i = rho & 15; return 8 * (i >> 2) + 4 * n + (i & 3); }
__device__ __forceinline__ unsigned cvt_pk_bf16(float lo, float hi) { unsigned r; asm volatile("v_cvt_pk_bf16_f32 %0, %1, %2" : "=v"(r) : "v"(lo), "v"(hi)); return r; }

struct Unit { int pm, pn, e, mt, ce, half, ord; };

__device__ __forceinline__ bool tail_split(int i, int G, int c, int total, int& U, int& half) {
    const int fullr = total / G, rem = total - fullr * G; const bool split = rem > 0 && 2 * rem <= G; const int L = i * G + c; half = 0;
    if (!split || L < fullr * G) { if (L >= total) return false; U = L; return true; }
    const int t2 = L - fullr * G; if (t2 >= 2 * rem) return false; U = fullr * G + (t2 >> 1); half = 1 + (t2 & 1); return true;
}
struct DenseOrder {
    int nM, nN, nwg, G, c, esz; const void* Bt;
    __device__ void init(int M_, int N_, int G_, int c_, const void* Bt_, int esz_ = 2) { nM = M_ / BM; nN = N_ / BM; nwg = nM * nN; G = G_; c = c_; Bt = Bt_; esz = esz_; }
    __device__ __forceinline__ bool next(int i, Unit& u) const {
        int U, hf; if (!tail_split(i, G, c, nwg, U, hf)) return false;
        int wgid = U; u.half = hf; u.ord = i; { const int q = nwg / NXCD, r = nwg % NXCD, xcd = wgid % NXCD, off = wgid / NXCD; wgid = (xcd < r ? xcd * (q + 1) : r * (q + 1) + (xcd - r) * q) + off; }
        const int nig = WGM * nN, gid = wgid / nig, fm = gid * WGM, gsz = (nM - fm) < WGM ? (nM - fm) : WGM;
        u.pm = fm + ((wgid % nig) % gsz); u.pn = (wgid % nig) / gsz; u.e = 0; u.mt = 0; u.ce = 0; return true;
    }
    __device__ __forceinline__ unsigned arow(const Unit& u, int r) const { return (unsigned)(u.pm * BM + (u.half ? (u.half - 1) * HALF + (r & (HALF - 1)) : r)); }
    __device__ __forceinline__ const char* bbase(const Unit& u) const { return (const char*)Bt + (size_t)u.pn * BM * GK * esz; }
    __device__ __forceinline__ void preload(LAS unsigned char*, int) const {}
};
struct ExpertOrder {
    const LAS int* tab; int NT, MG, G, c; const void* Bt; size_t bstride; const int* seg; bool gather; int esz; LAS unsigned short* gidx;
    __device__ __forceinline__ bool next(int i, Unit& u) const {
#if EXPERT_XCD_ORDER
        const int x = c & 7, S = G >> 3; int L, hf; if (!tail_split(i, S, c >> 3, tab[448 + 8 * x + 4], L, hf)) return false;
        int q = 0;
#pragma unroll
        for (int k = 1; k < 4; ++k) q += (tab[448 + 8 * x + k] <= L) ? 1 : 0;
        const int e = x + 8 * q, r = L - tab[448 + 8 * x + q], ce = tab[e], nt_e = (ce + 255) >> 8;
        const int per = MG * NT, grp = r / per, w = r - grp * per;
        const int gsz = (nt_e - grp * MG) < MG ? (nt_e - grp * MG) : MG;
        u.mt = grp * MG + (w % gsz); u.pn = w / gsz; u.e = e; u.ce = ce; u.pm = tab[32 + e] + u.mt; u.half = hf; u.ord = i; return true;
#else
        const int cc = (G & 7) ? c : (c & 7) * (G >> 3) + (c >> 3);
        int U, hf; if (!tail_split(i, G, cc, tab[64 + 32] * NT, U, hf)) return false;
#if EXPERT_GROUP4
        const int T_ = tab[64 + 32], per = 4 * NT, grp = U / per, w = U - grp * per, gsz = (T_ - 4 * grp) < 4 ? (T_ - 4 * grp) : 4;
        const int tile = 4 * grp + (w % gsz); u.pn = w / gsz; u.half = hf; u.ord = i;
#else
        const int tile = U / NT; u.pn = U - tile * NT; u.half = hf; u.ord = i;
#endif
        const int e = tab[128 + tile];
        u.e = e; u.mt = tile - tab[64 + e]; u.pm = tab[32 + e] + u.mt; u.ce = tab[e];
        if (u.half == 0 && u.ce - u.mt * BM <= HALF) u.half = 1;
        return true;
#endif
    }
    __device__ __forceinline__ unsigned arow_g(const Unit& u, int r) const {
        const int rr = u.half ? (u.half - 1) * HALF + (r & (HALF - 1)) : r;
        if (!gather) return (unsigned)(u.pm * BM + rr);
        const int slot = u.mt * BM + rr; return slot < u.ce ? (unsigned)seg[u.e * M + slot] : 0u;
    }
    __device__ __forceinline__ unsigned arow(const Unit& u, int r) const {
        if (gather && u.ord < MAXORD) return (unsigned)gidx[u.ord * 256 + r];
        return arow_g(u, r);
    }
    __device__ __forceinline__ void preload(LAS unsigned char* ldsbase, int tid) const {
        if (!gather) return;
        for (int i = 0; i < MAXORD; ++i) { Unit u; if (!next(i, u)) break; if (tid < 256) gidx[i * 256 + tid] = (unsigned short)arow_g(u, tid); }
    }
    __device__ __forceinline__ const char* bbase(const Unit& u) const { return (const char*)Bt + ((size_t)u.e * bstride + (size_t)u.pn * BM * GK) * esz; }
};
__device__ __forceinline__ void expert_table(const int* cnt, LAS int* tab, int NT, const int tid) {
    if (tid == 0) { int ps = 0; for (int e = 0; e < NE; ++e) { const int c = __hip_atomic_load(cnt + e, __ATOMIC_RELAXED, __HIP_MEMORY_SCOPE_AGENT); tab[e] = c; tab[32 + e] = ps; tab[64 + e] = ps; ps += (c + 255) >> 8; } tab[64 + 32] = ps; }
    __syncthreads();
    if (tid < NE) { const int t0 = tab[64 + tid], t1 = tab[64 + tid + 1]; for (int t = t0; t < t1; ++t) tab[128 + t] = tid; }
    if (tid >= 64 && tid < 72) { const int x = tid - 64; int t = 0; for (int q = 0; q < 4; ++q) { tab[448 + 8 * x + q] = t; t += ((tab[x + 8 * q] + 255) >> 8) * NT; } tab[448 + 8 * x + 4] = t; }
    __syncthreads();
}

struct EpiProj {
    static constexpr bool PERM = true;
    template <class Sched> __device__ __forceinline__ void preload(const Sched&, int) const {}
    bf16_t* O; int ldc;
    __device__ __forceinline__ void operator()(const f32x4 (&acc)[2][2][4][2], const Unit& u, int wr, int wc, int fr, int fq) const {
        const int nai = u.half ? 1 : 2; const int row0 = u.pm * BM + (u.half == 2 ? HALF : 0) + wr * 64 + fr, col0 = u.pn * BM + wc * 32 + 8 * fq;
#pragma unroll
        for (int ai = 0; ai < 2; ++ai) if (ai < nai)
#pragma unroll
            for (int m = 0; m < 4; ++m) { bf16_t* rowp = O + (size_t)(row0 + ai * HALF + m * 16) * ldc + col0;
#pragma unroll
                for (int bj = 0; bj < 2; ++bj) { const f32x4 v0 = acc[ai][bj][m][0], v1 = acc[ai][bj][m][1];
                    u32x4 w; w.x = cvt_pk_bf16(v0[0], v0[1]); w.y = cvt_pk_bf16(v0[2], v0[3]); w.z = cvt_pk_bf16(v1[0], v1[1]); w.w = cvt_pk_bf16(v1[2], v1[3]);
                    *(u32x4*)(rowp + bj * HALF) = w; } }
    }
};
struct EpiProjI8 {
    static constexpr bool PERM = true;
    bf16_t* O; int ldc; const float* sA; const unsigned* cmax; LAS float* lb;
    template <class Sched> __device__ __forceinline__ void preload(const Sched& S, int tid) const {
        for (int i = 0; i < MAXORD / 2; ++i) { Unit u; if (!S.next(i, u)) break;
            if (tid < 256) lb[i * 512 + tid] = sA[S.arow(u, tid)]; else lb[i * 512 + tid] = __uint_as_float(cmax[u.pn * BM + tid - 256]) * (1.f / 127.f); }
    }
    __device__ __forceinline__ void operator()(const f32x4 (&acc)[2][2][4][2], const Unit& u, int wr, int wc, int fr, int fq) const {
        const int nai = u.half ? 1 : 2; const int row0 = u.pm * BM + (u.half == 2 ? HALF : 0) + wr * 64 + fr, col0 = u.pn * BM + wc * 32 + 8 * fq;
        const LAS float* l = lb + u.ord * 512;
        f32x4 cs[2][2];
#pragma unroll
        for (int bj = 0; bj < 2; ++bj)
#pragma unroll
            for (int n = 0; n < 2; ++n) cs[bj][n] = *(const LAS f32x4*)(l + 256 + wc * 32 + 8 * fq + bj * HALF + 4 * n);
#pragma unroll
        for (int ai = 0; ai < 2; ++ai) if (ai < nai)
#pragma unroll
            for (int m = 0; m < 4; ++m) { bf16_t* rowp = O + (size_t)(row0 + ai * HALF + m * 16) * ldc + col0; const float rs = l[ai * HALF + wr * 64 + m * 16 + fr];
#pragma unroll
                for (int bj = 0; bj < 2; ++bj) { const i32x4 a0 = __builtin_bit_cast(i32x4, acc[ai][bj][m][0]), a1 = __builtin_bit_cast(i32x4, acc[ai][bj][m][1]);
                    const f32x4 v0 = __builtin_convertvector(a0, f32x4) * rs * cs[bj][0], v1 = __builtin_convertvector(a1, f32x4) * rs * cs[bj][1];
                    u32x4 w; w.x = cvt_pk_bf16(v0[0], v0[1]); w.y = cvt_pk_bf16(v0[2], v0[3]); w.z = cvt_pk_bf16(v1[0], v1[1]); w.w = cvt_pk_bf16(v1[2], v1[3]);
                    st16_wt(rowp + bj * HALF, w); } }
    }
};
template <bool XF32> struct EpiResidB {
    static constexpr bool PERM = true;
    const float* ssq; LAS float* lb;
    template <class Sched> __device__ __forceinline__ void preload(const Sched& S, int tid) const {
        if (!ssq) return;
        for (int i = 0; i < MAXORD / 2; ++i) { Unit u; if (!S.next(i, u)) break;
            if (tid < 256) { const float* p = ssq + (size_t)S.arow(u, tid) * 8; const f32x4 a = *(const f32x4*)p, b = *(const f32x4*)(p + 4);
                lb[i * 256 + tid] = 1.0f / sqrtf(((a.x + a.y) + (a.z + a.w) + (b.x + b.y) + (b.z + b.w)) * (1.f / 512.f) + EPS); } }
    }
    __device__ __forceinline__ float rowscale(const Unit& u, int rlocal) const { return lb[u.ord * 256 + rlocal]; }
    const void* xin; bf16_t* out;
    __device__ __forceinline__ void operator()(const f32x4 (&acc)[2][2][4][2], const Unit& u, int wr, int wc, int fr, int fq) const {
        const int nai = u.half ? 1 : 2; const int row0 = u.pm * BM + (u.half == 2 ? HALF : 0) + wr * 64 + fr, col0 = u.pn * BM + wc * 32 + 8 * fq;
#pragma unroll
        for (int ai = 0; ai < 2; ++ai) if (ai < nai)
#pragma unroll
            for (int m = 0; m < 4; ++m) { const size_t off = (size_t)(row0 + ai * HALF + m * 16) * D + col0;
#pragma unroll
                for (int bj = 0; bj < 2; ++bj) { f32x4 v0 = acc[ai][bj][m][0], v1 = acc[ai][bj][m][1];
                    if constexpr (XF32) { const float* xp = (const float*)xin + off + bj * HALF; v0 += *(const f32x4*)xp; v1 += *(const f32x4*)(xp + 4); }
                    else { const u32x4 r = *(const u32x4*)((const bf16_t*)xin + off + bj * HALF);
                        v0[0] += __uint_as_float(r.x << 16); v0[1] += __uint_as_float(r.x & 0xffff0000u); v0[2] += __uint_as_float(r.y << 16); v0[3] += __uint_as_float(r.y & 0xffff0000u);
                        v1[0] += __uint_as_float(r.z << 16); v1[1] += __uint_as_float(r.z & 0xffff0000u); v1[2] += __uint_as_float(r.w << 16); v1[3] += __uint_as_float(r.w & 0xffff0000u); }
                    u32x4 w; w.x = cvt_pk_bf16(v0[0], v0[1]); w.y = cvt_pk_bf16(v0[2], v0[3]); w.z = cvt_pk_bf16(v1[0], v1[1]); w.w = cvt_pk_bf16(v1[2], v1[3]);
                    *(u32x4*)(out + off + bj * HALF) = w; } }
    }
};
struct EpiResidI8 {
    static constexpr bool PERM = false;
    const float* xin; float* out; const float* sM; const unsigned* cmax; LAS float* lb;
    template <class Sched> __device__ __forceinline__ void preload(const Sched& S, int tid) const {
        for (int i = 0; i < MAXORD / 2; ++i) { Unit u; if (!S.next(i, u)) break;
            if (tid < 256) lb[i * 512 + tid] = sM[S.arow(u, tid)]; else lb[i * 512 + tid] = __uint_as_float(cmax[u.pn * BM + tid - 256]) * (1.f / 127.f); }
    }
    __device__ __forceinline__ void operator()(const f32x4 (&acc)[2][2][4][2], const Unit& u, int wr, int wc, int fr, int fq) const {
        const int nai = u.half ? 1 : 2; const int row0 = u.pm * BM + (u.half == 2 ? HALF : 0) + wr * 64 + fr, col0 = u.pn * BM + wc * 32 + 4 * fq;
        const LAS float* l = lb + u.ord * 512;
        f32x4 cs[2][2];
#pragma unroll
        for (int bj = 0; bj < 2; ++bj)
#pragma unroll
            for (int n = 0; n < 2; ++n) cs[bj][n] = *(const LAS f32x4*)(l + 256 + wc * 32 + 4 * fq + bj * HALF + 16 * n);
#pragma unroll
        for (int ai = 0; ai < 2; ++ai) if (ai < nai)
#pragma unroll
            for (int m = 0; m < 4; ++m) { const size_t off = (size_t)(row0 + ai * HALF + m * 16) * D + col0; const float rs = l[ai * HALF + wr * 64 + m * 16 + fr];
#pragma unroll
                for (int bj = 0; bj < 2; ++bj)
#pragma unroll
                    for (int n = 0; n < 2; ++n) { const f32x4 x = *(const f32x4*)(xin + off + bj * HALF + n * 16);
                        *(f32x4*)(out + off + bj * HALF + n * 16) = x + __builtin_convertvector(__builtin_bit_cast(i32x4, acc[ai][bj][m][n]), f32x4) * rs * cs[bj][n]; } }
    }
};
struct EpiResid {
    static constexpr bool PERM = false;
    const float* ssq; LAS float* lb;
    template <class Sched> __device__ __forceinline__ void preload(const Sched& S, int tid) const {
        if (!ssq) return;
        for (int i = 0; i < MAXORD / 2; ++i) { Unit u; if (!S.next(i, u)) break;
            if (tid < 256) { const float* p = ssq + (size_t)S.arow(u, tid) * 8; const f32x4 a = *(const f32x4*)p, b = *(const f32x4*)(p + 4);
                lb[i * 256 + tid] = 1.0f / sqrtf(((a.x + a.y) + (a.z + a.w) + (b.x + b.y) + (b.z + b.w)) * (1.f / 512.f) + EPS); } }
    }
    __device__ __forceinline__ float rowscale(const Unit& u, int rlocal) const { return lb[u.ord * 256 + rlocal]; }
    const float* xin; float* out;
    __device__ __forceinline__ void operator()(const f32x4 (&acc)[2][2][4][2], const Unit& u, int wr, int wc, int fr, int fq) const {
        const int nai = u.half ? 1 : 2; const int row0 = u.pm * BM + (u.half == 2 ? HALF : 0) + wr * 64 + fr, col0 = u.pn * BM + wc * 32 + 4 * fq;
#pragma unroll
        for (int ai = 0; ai < 2; ++ai) if (ai < nai)
#pragma unroll
            for (int m = 0; m < 4; ++m) { const size_t off = (size_t)(row0 + ai * HALF + m * 16) * D + col0;
#pragma unroll
                for (int bj = 0; bj < 2; ++bj)
#pragma unroll
                    for (int n = 0; n < 2; ++n) { const f32x4 x = *(const f32x4*)(xin + off + bj * HALF + n * 16); *(f32x4*)(out + off + bj * HALF + n * 16) = x + acc[ai][bj][m][n]; } }
    }
};
__device__ __forceinline__ unsigned pk4_fp8(float a, float b, float c, float d) { int v = __builtin_amdgcn_cvt_pk_fp8_f32(a, b, 0, false); v = __builtin_amdgcn_cvt_pk_fp8_f32(c, d, v, true); return (unsigned)v; }
template <bool F8> struct EpiGU {
    static constexpr bool PERM = true;
    void* act; const float* bg; const float* bu; LAS float* lb;
    template <class Sched> __device__ __forceinline__ void preload(const Sched& S, int tid) const {
        for (int i = 0; i < MAXORD; ++i) { Unit u; if (!S.next(i, u)) break; if (tid >= 256) { const int t = tid - 256; lb[i * 256 + t] = (t < 128 ? bg : bu)[u.e * DE + u.pn * HALF + (t & 127)]; } }
    }
    __device__ __forceinline__ void operator()(const f32x4 (&acc)[2][2][4][2], const Unit& u, int wr, int wc, int fr, int fq) const {
        const int nai = u.half ? 1 : 2; const int row0 = u.pm * BM + (u.half == 2 ? HALF : 0) + wr * 64 + fr, col0 = u.pn * HALF + wc * 32 + 8 * fq;
        f32x4 g0, g1, u0, u1;
        if (u.ord < MAXORD) { const LAS float* p = lb + u.ord * 256 + wc * 32 + 8 * fq; g0 = *(const LAS f32x4*)p; g1 = *(const LAS f32x4*)(p + 4); u0 = *(const LAS f32x4*)(p + 128); u1 = *(const LAS f32x4*)(p + 132); }
        else { g0 = *(const f32x4*)(bg + u.e * DE + col0); g1 = *(const f32x4*)(bg + u.e * DE + col0 + 4); u0 = *(const f32x4*)(bu + u.e * DE + col0); u1 = *(const f32x4*)(bu + u.e * DE + col0 + 4); }
        constexpr float sc = F8 ? (1.f / 4096.f) : 1.f, os = F8 ? 4.f : 1.f;
        typedef float f32x2_ __attribute__((ext_vector_type(2)));
        constexpr float KG = -1.702f * 1.4426950408889634f, scg = sc * KG, scu = sc * os / KG, ulo = -6.f * os / KG, uhi = 8.f * os / KG;
        f32x2_ gk[4], uk[4];
#pragma unroll
        for (int jp = 0; jp < 2; ++jp) { gk[jp] = (f32x2_){g0[2 * jp], g0[2 * jp + 1]} * KG; gk[2 + jp] = (f32x2_){g1[2 * jp], g1[2 * jp + 1]} * KG;
            uk[jp] = ((f32x2_){u0[2 * jp], u0[2 * jp + 1]} + 1.f) * (os / KG); uk[2 + jp] = ((f32x2_){u1[2 * jp], u1[2 * jp + 1]} + 1.f) * (os / KG); }
#pragma unroll
        for (int ai = 0; ai < 2; ++ai) if (ai < nai)
#pragma unroll
            for (int m = 0; m < 4; ++m) {
                float r[8];
#pragma unroll
                for (int n = 0; n < 2; ++n)
#pragma unroll
                    for (int jp = 0; jp < 2; ++jp) { const f32x2_ a2 = {acc[ai][0][m][n][2 * jp], acc[ai][0][m][n][2 * jp + 1]}, b2 = {acc[ai][1][m][n][2 * jp], acc[ai][1][m][n][2 * jp + 1]};
                        f32x2_ gs = a2 * scg + gk[n * 2 + jp], uu = b2 * scu + uk[n * 2 + jp];
                        gs.x = fmaxf(gs.x, 7.f * KG); gs.y = fmaxf(gs.y, 7.f * KG);
                        uu.x = __builtin_amdgcn_fmed3f(uu.x, ulo, uhi); uu.y = __builtin_amdgcn_fmed3f(uu.y, ulo, uhi);
                        f32x2_ e = {__builtin_amdgcn_exp2f(gs.x), __builtin_amdgcn_exp2f(gs.y)}; e = e + 1.f;
                        const f32x2_ sg = {__builtin_amdgcn_rcpf(e.x), __builtin_amdgcn_rcpf(e.y)};
                        const f32x2_ rr = (gs * sg) * uu; r[n * 4 + 2 * jp] = rr.x; r[n * 4 + 2 * jp + 1] = rr.y; }
                if constexpr (F8) { u32x2 w; w.x = pk4_fp8(r[0], r[1], r[2], r[3]); w.y = pk4_fp8(r[4], r[5], r[6], r[7]);
                    *(u32x2*)((unsigned char*)act + (size_t)(row0 + ai * HALF + m * 16) * DE + col0) = w; }
                else { u32x4 w; w.x = cvt_pk_bf16(r[0], r[1]); w.y = cvt_pk_bf16(r[2], r[3]); w.z = cvt_pk_bf16(r[4], r[5]); w.w = cvt_pk_bf16(r[6], r[7]);
                    *(u32x4*)((bf16_t*)act + (size_t)(row0 + ai * HALF + m * 16) * DE + col0) = w; } }
    }
};
template <bool F8> struct EpiDown {
    static constexpr bool PERM = true;
    bf16_t* ys; const float* bd; LAS float* lb;
    template <class Sched> __device__ __forceinline__ void preload(const Sched& S, int tid) const {
        for (int i = 0; i < MAXORD; ++i) { Unit u; if (!S.next(i, u)) break; if (tid >= 256) { const int t = tid - 256; lb[i * 256 + t] = bd[u.e * D + u.pn * BM + t]; } }
    }
    __device__ __forceinline__ void operator()(const f32x4 (&acc)[2][2][4][2], const Unit& u, int wr, int wc, int fr, int fq) const {
        const int nai = u.half ? 1 : 2; const int row0 = u.pm * BM + (u.half == 2 ? HALF : 0) + wr * 64 + fr, col0 = u.pn * BM + wc * 32 + 8 * fq;
        constexpr float sc = F8 ? (1.f / 1024.f) : 1.f;
        f32x4 bv[2][2];
#pragma unroll
        for (int bj = 0; bj < 2; ++bj)
#pragma unroll
            for (int n = 0; n < 2; ++n) { bv[bj][n] = u.ord < MAXORD ? *(const LAS f32x4*)(lb + u.ord * 256 + wc * 32 + 8 * fq + bj * HALF + 4 * n) : *(const f32x4*)(bd + u.e * D + col0 + bj * HALF + 4 * n); if (YS_F8) bv[bj][n] *= 8.f; }
#pragma unroll
        for (int ai = 0; ai < 2; ++ai) if (ai < nai)
#pragma unroll
            for (int m = 0; m < 4; ++m) { bf16_t* rowp = ys + (size_t)(row0 + ai * HALF + m * 16) * D + col0;
#pragma unroll
                for (int bj = 0; bj < 2; ++bj) { constexpr float sc8 = YS_F8 ? 8.f * sc : sc; const f32x4 v0 = acc[ai][bj][m][0] * sc8 + bv[bj][0], v1 = acc[ai][bj][m][1] * sc8 + bv[bj][1];
#if YS_F8
                    u32x2 w; w.x = pk4_fp8(v0[0], v0[1], v0[2], v0[3]); w.y = pk4_fp8(v1[0], v1[1], v1[2], v1[3]);
                    *(u32x2*)((unsigned char*)ys + (size_t)(row0 + ai * HALF + m * 16) * D + col0 + bj * HALF) = w; (void)rowp;
#else
                    u32x4 w; w.x = cvt_pk_bf16(v0[0], v0[1]); w.y = cvt_pk_bf16(v0[2], v0[3]); w.z = cvt_pk_bf16(v1[0], v1[1]); w.w = cvt_pk_bf16(v1[2], v1[3]);
                    *(u32x4*)(rowp + bj * HALF) = w;
#endif
                } }
    }
};

template <class Epi, class Sched, bool ALIGN_EPI, int DT = 0, int PROBE = 0, bool MIDSCALE = false>
__device__ __forceinline__ void gemm_phase(LAS unsigned char* lds, const void* Aptr, const Sched& S, const Epi& E, const int tid) {
    const int wid = __builtin_amdgcn_readfirstlane(tid >> 6), lane = tid & 63, wr = wid >> 2, wc = wid & 3, fr = lane & 15, fq = lane >> 4;
    constexpr bool F8 = DT == 1, I8 = DT == 2; constexpr int KB = DT ? GK : 2 * GK, nt = KB / 128;
    const char* Ab = (const char*)Aptr;
    int sR[2], sC[2]; unsigned voffB[2];
#pragma unroll
    for (int i = 0; i < 2; ++i) { int R, C; stage_rc(tid * 16 + i * 8192, R, C); sR[i] = R; sC[i] = C; const int Rb = Epi::PERM ? ((R & ~31) + perm32(R & 31)) : R; voffB[i] = (unsigned)(Rb * KB + 2 * C); }
    constexpr size_t kstep = (size_t)(BK * 2);
    constexpr size_t hstep = (size_t)HALF * KB;
    const unsigned ldsw = (unsigned)wid * 1024u;
    const int aoff = lds_byte(wr * 64 + fr, fq * 8), boff = lds_byte(wc * 32 + fr, fq * 8);
    const int a8off = lds_byte_b(wr * 64 + fr, fq * 32), b8off = lds_byte_b(wc * 32 + fr, fq * 32); (void)aoff; (void)boff; (void)a8off; (void)b8off;
#define G8_SA(b, h) (((b) * 2 + (h)) * HTB)
#define G8_SB(b, h) ((4 + (b) * 2 + (h)) * HTB)
#define G8_STAGE(bufoff, gbase, voff) do { _Pragma("unroll") for (int _i = 0; _i < 2; ++_i) \
        __builtin_amdgcn_global_load_lds((const unsigned*)((const char*)(gbase) + (voff)[_i]), (LAS unsigned*)(lds + (bufoff) + ldsw + _i * 8192), 16, 0, 0); } while (0)
#define G8_LDA(dst, dst8, b, h) do { if constexpr (F8) { _Pragma("unroll") for (int m = 0; m < 4; ++m) { const i32x4 lo_ = *(const LAS i32x4*)(lds + G8_SA(b, h) + a8off + m * 2048), hi_ = *(const LAS i32x4*)(lds + G8_SA(b, h) + a8off + m * 2048 + 16); \
            dst8[m] = __builtin_shufflevector(lo_, hi_, 0, 1, 2, 3, 4, 5, 6, 7); } } \
        else { _Pragma("unroll") for (int m = 0; m < 4; ++m) _Pragma("unroll") for (int k = 0; k < 2; ++k) dst[m][k] = *(const LAS bf16x8*)(lds + G8_SA(b, h) + aoff + m * 2048 + k * 1024); } } while (0)
#define G8_LDB(dst, dst8, b, h) do { if constexpr (F8) { _Pragma("unroll") for (int n = 0; n < 2; ++n) { const i32x4 lo_ = *(const LAS i32x4*)(lds + G8_SB(b, h) + b8off + n * 2048), hi_ = *(const LAS i32x4*)(lds + G8_SB(b, h) + b8off + n * 2048 + 16); \
            dst8[n] = __builtin_shufflevector(lo_, hi_, 0, 1, 2, 3, 4, 5, 6, 7); } } \
        else { _Pragma("unroll") for (int n = 0; n < 2; ++n) _Pragma("unroll") for (int k = 0; k < 2; ++k) dst[n][k] = *(const LAS bf16x8*)(lds + G8_SB(b, h) + boff + n * 2048 + k * 1024); } } while (0)
#define G8_MMA(ai, bj, At, At8, Bt, Bt8) do { __builtin_amdgcn_s_setprio(1); if constexpr (PROBE & 1) { _Pragma("unroll") for (int m = 0; m < 4; ++m) asm volatile("" :: "v"(At8[m]), "v"(Bt8[m & 1])); } else if constexpr (F8) { _Pragma("unroll") for (int m = 0; m < 4; ++m) _Pragma("unroll") for (int n = 0; n < 2; ++n) \
            asm volatile("v_mfma_f32_16x16x128_f8f6f4 %0, %1, %2, %0" : "+v"(acc[ai][bj][m][n]) : "v"(Bt8[n]), "v"(At8[m])); } \
        else if constexpr (I8) { _Pragma("unroll") for (int m = 0; m < 4; ++m) _Pragma("unroll") for (int n = 0; n < 2; ++n) _Pragma("unroll") for (int k = 0; k < 2; ++k) \
            acc[ai][bj][m][n] = __builtin_bit_cast(f32x4, __builtin_amdgcn_mfma_i32_16x16x64_i8(__builtin_bit_cast(i32x4, Bt[n][k]), __builtin_bit_cast(i32x4, At[m][k]), __builtin_bit_cast(i32x4, acc[ai][bj][m][n]), 0, 0, 0)); } \
        else { _Pragma("unroll") for (int m = 0; m < 4; ++m) _Pragma("unroll") for (int n = 0; n < 2; ++n) _Pragma("unroll") for (int k = 0; k < 2; ++k) \
            acc[ai][bj][m][n] = __builtin_amdgcn_mfma_f32_16x16x32_bf16(Bt[n][k], At[m][k], acc[ai][bj][m][n], 0, 0, 0); } __builtin_amdgcn_s_setprio(0); } while (0)
#define G8_WAIT_V(n) asm volatile("s_waitcnt vmcnt(" #n ")" ::: "memory")
#define G8_WAIT_L(n) asm volatile("s_waitcnt lgkmcnt(" #n ")" ::: "memory")
#define G8_BAR __builtin_amdgcn_s_barrier()
#define G8_SCHED __builtin_amdgcn_sched_barrier(0)
#define G8_ROWS(dst, u) do { _Pragma("unroll") for (int _h = 0; _h < 2; ++_h) _Pragma("unroll") for (int _i = 0; _i < 2; ++_i) dst[_h][_i] = S.arow(u, _h * HALF + sR[_i]) * (unsigned)KB + 2u * (unsigned)sC[_i]; } while (0)
    S.preload(lds, tid); E.preload(S, tid);
    __syncthreads();
    Unit cur, nxt; int ui = 0;
    if (!S.next(0, cur)) return;
    f32x4 acc[2][2][4][2];
#pragma unroll
    for (int a = 0; a < 2; ++a)
#pragma unroll
        for (int b = 0; b < 2; ++b)
#pragma unroll
            for (int m = 0; m < 4; ++m)
#pragma unroll
                for (int n = 0; n < 2; ++n) acc[a][b][m][n] = (f32x4){0.f, 0.f, 0.f, 0.f};
    bf16x8 At[4][2], B0[2][2], B1[2][2]; v8i At8[4], B08[2], B18[2];
    unsigned arc[2][2], arn[2][2];
    G8_ROWS(arc, cur);
    const char* cB = S.bbase(cur);
    G8_STAGE(G8_SB(0, 0), cB, voffB); G8_STAGE(G8_SB(0, 1), cB + hstep, voffB); G8_STAGE(G8_SA(0, 0), Ab, arc[0]); G8_STAGE(G8_SA(0, 1), Ab, arc[1]);
    if (wr == 1) G8_BAR;
    G8_WAIT_V(2); G8_BAR;
    G8_STAGE(G8_SB(1, 0), cB + kstep, voffB); G8_STAGE(G8_SA(1, 0), Ab + kstep, arc[0]); G8_STAGE(G8_SB(1, 1), cB + hstep + kstep, voffB);
    G8_WAIT_V(6); G8_BAR;
    for (;;) {
        const bool has_next = S.next(ui + 1, nxt);
        const char* nB = cB;
        if (has_next) { G8_ROWS(arn, nxt); nB = S.bbase(nxt); }
        else {
#pragma unroll
            for (int h = 0; h < 2; ++h)
#pragma unroll
                for (int i = 0; i < 2; ++i) arn[h][i] = arc[h][i];
        }
#pragma unroll 1
        for (int t = 0; t < nt; t += 2) {
            const bool last = (t == nt - 2);
            if constexpr (MIDSCALE) { if (t == nt / 2) {
#pragma unroll
                for (int ai = 0; ai < 2; ++ai)
#pragma unroll
                    for (int m = 0; m < 4; ++m) { const float rs_ = E.rowscale(cur, ai * HALF + wr * 64 + m * 16 + fr);
#pragma unroll
                        for (int bj = 0; bj < 2; ++bj)
#pragma unroll
                            for (int n = 0; n < 2; ++n) acc[ai][bj][m][n] *= rs_; } } }
            const char* a1 = Ab + (size_t)(t + 1) * kstep;
            const char* a2 = last ? Ab : Ab + (size_t)(t + 2) * kstep; const char* b2 = last ? nB : cB + (size_t)(t + 2) * kstep;
            const char* a3 = a2 + kstep; const char* b3 = b2 + kstep;
            unsigned ar2[2][2];
#pragma unroll
            for (int h = 0; h < 2; ++h)
#pragma unroll
                for (int i = 0; i < 2; ++i) ar2[h][i] = last ? arn[h][i] : arc[h][i];
            G8_LDB(B0, B08, 0, 0); G8_LDB(B1, B18, 0, 1); G8_SCHED; G8_LDA(At, At8, 0, 0); G8_STAGE(G8_SA(1, 1), a1, arc[1]);
            G8_WAIT_V(8); G8_WAIT_L(0); G8_BAR; G8_MMA(0, 0, At, At8, B0, B08); G8_MMA(0, 1, At, At8, B1, B18); G8_BAR; G8_SCHED;
            G8_LDA(At, At8, 0, 1); G8_STAGE(G8_SB(0, 0), b2, voffB); G8_STAGE(G8_SB(0, 1), b2 + hstep, voffB); G8_STAGE(G8_SA(0, 0), a2, ar2[0]);
            G8_WAIT_V(8); G8_WAIT_L(0); G8_BAR; if (!cur.half) { G8_MMA(1, 0, At, At8, B0, B08); G8_MMA(1, 1, At, At8, B1, B18); } G8_BAR; G8_SCHED;
            G8_LDB(B0, B08, 1, 0); G8_LDB(B1, B18, 1, 1); G8_SCHED; G8_LDA(At, At8, 1, 0); G8_STAGE(G8_SA(0, 1), a2, ar2[1]);
            G8_WAIT_V(8); G8_WAIT_L(0); G8_BAR; G8_MMA(0, 0, At, At8, B0, B08); G8_MMA(0, 1, At, At8, B1, B18); G8_BAR; G8_SCHED;
            G8_LDA(At, At8, 1, 1); G8_STAGE(G8_SB(1, 0), b3, voffB); G8_STAGE(G8_SB(1, 1), b3 + hstep, voffB); G8_STAGE(G8_SA(1, 0), a3, ar2[0]);
            G8_WAIT_V(8); G8_WAIT_L(0); G8_BAR; if (!cur.half) { G8_MMA(1, 0, At, At8, B0, B08); G8_MMA(1, 1, At, At8, B1, B18); } G8_BAR; G8_SCHED;
        }
        if constexpr (ALIGN_EPI) { if (wr == 0) G8_BAR; }
        if constexpr (F8) asm volatile("s_nop 15\n\ts_nop 15" ::: "memory");
        if constexpr (!(PROBE & 2)) E(acc, cur, wr, wc, fr, fq); else { _Pragma("unroll") for (int m = 0; m < 4; ++m) asm volatile("" :: "v"(acc[0][0][m][0]), "v"(acc[1][1][m][1])); }
        if (!has_next) break;
#pragma unroll
        for (int a = 0; a < 2; ++a)
#pragma unroll
            for (int b = 0; b < 2; ++b)
#pragma unroll
                for (int m = 0; m < 4; ++m)
#pragma unroll
                    for (int n = 0; n < 2; ++n) acc[a][b][m][n] = (f32x4){0.f, 0.f, 0.f, 0.f};
        cur = nxt; cB = nB; ++ui;
#pragma unroll
        for (int h = 0; h < 2; ++h)
#pragma unroll
            for (int i = 0; i < 2; ++i) arc[h][i] = arn[h][i];
        if constexpr (ALIGN_EPI) { if (wr == 1) G8_BAR; }
    }
    G8_WAIT_V(0);
    if constexpr (!ALIGN_EPI) { if (wr == 0) G8_BAR; }
    G8_BAR;
#undef G8_SA
#undef G8_SB
#undef G8_STAGE
#undef G8_LDA
#undef G8_LDB
#undef G8_MMA
#undef G8_WAIT_V
#undef G8_WAIT_L
#undef G8_BAR
#undef G8_SCHED
#undef G8_ROWS
}
}
namespace attn_body {
using bf16=unsigned short;

using s16x4=__attribute__((ext_vector_type(4)))short;
using f32x16=__attribute__((ext_vector_type(16)))float;

constexpr int BATCH=2,NHEAD=8,SEQ=8192,D=64,QP=2560,KP=2560,VP=2560,OP=1024;
constexpr int NW=8,QBLK=32,QB=QBLK*NW,KVBLK=64,NQB=SEQ/QB;
constexpr int ATTN_UNIT_ROWS=QB;
__device__ __forceinline__ int crow(int r,int hi){return (r&3)+8*(r>>2)+4*hi;}
#define SBAR() __builtin_amdgcn_sched_barrier(0)
__device__ __forceinline__ void cmask(f32x16&p0,f32x16&p1,int jb,int qrel,int hi){
  const float NEG=-INFINITY; int kb=64*jb+4*hi;
  #pragma unroll
  for(int r=0;r<16;++r){int kv=kb+(r&3)+8*(r>>2); if(kv>qrel)p0[r]=NEG; if(kv+32>qrel)p1[r]=NEG;}
}

constexpr int NSLOT=3, SLOTB=8192;
constexpr int LDS_K=0, LDS_V=NSLOT*SLOTB, LDS_WS=2*NSLOT*SLOTB, LDS_OST=LDS_WS+NW*64*4, LDS_BYTES=LDS_OST+NW*4096;
__device__ __forceinline__ void glds16(const void*gsrc,unsigned lds_dst){unsigned keep;
  asm volatile("s_mov_b32 %0, m0\n\ts_mov_b32 m0, %2\n\ts_nop 0\n\tglobal_load_lds_dwordx4 %1, off\n\ts_mov_b32 m0, %0":"=&s"(keep):"v"(gsrc),"s"(lds_dst):"memory");}
__device__ __forceinline__ float max3f(float a,float b,float c){float r;asm("v_max3_f32 %0, %1, %2, %3":"=v"(r):"v"(a),"v"(b),"v"(c));return r;}
__device__ __forceinline__ float max2f(float a,float b){float r;asm("v_max_f32_e32 %0, %1, %2":"=v"(r):"v"(a),"v"(b));return r;}
__device__ __forceinline__ float fadd_s(float a,float b){float r;asm("v_add_f32_e32 %0, %1, %2":"=v"(r):"v"(a),"v"(b));return r;}
__device__ __forceinline__ float fsub_s(float a,float b){float r;asm("v_sub_f32_e32 %0, %1, %2":"=v"(r):"v"(a),"v"(b));return r;}
typedef float f32x2_t __attribute__((ext_vector_type(2))); typedef __bf16 bf16x2_t __attribute__((ext_vector_type(2)));
__device__ __forceinline__ unsigned cvtpk_s(float lo,float hi){f32x2_t v={lo,hi};bf16x2_t b=__builtin_convertvector(v,bf16x2_t);return __builtin_bit_cast(unsigned,b);}
#define WAIT_BAR(N) asm volatile("s_waitcnt vmcnt(" #N ") lgkmcnt(0)\n\ts_barrier":::"memory")

__device__ __forceinline__ void qkt(f32x16&p0,f32x16&p1,const char*Kslot,const bf16x8*qr,const f32x16&negm,int r32,int hi){
  const char*kb=Kslot+hi*1024+r32*16;
  #pragma unroll
  for(int d0=0;d0<4;++d0){
    const bf16x8 b0=*reinterpret_cast<const bf16x8*>(kb+d0*2048);
    const bf16x8 b1=*reinterpret_cast<const bf16x8*>(kb+d0*2048+512);
    if(d0==0){p0=__builtin_amdgcn_mfma_f32_32x32x16_bf16(b0,qr[0],negm,0,0,0);p1=__builtin_amdgcn_mfma_f32_32x32x16_bf16(b1,qr[0],negm,0,0,0);}
    else{p0=__builtin_amdgcn_mfma_f32_32x32x16_bf16(b0,qr[d0],p0,0,0,0);p1=__builtin_amdgcn_mfma_f32_32x32x16_bf16(b1,qr[d0],p1,0,0,0);}}
}
typedef __attribute__((address_space(3))) const char* lds_cptr;
typedef short v4i16_t __attribute__((ext_vector_type(4)));
__device__ __forceinline__ void kload8(bf16x8*kf,lds_cptr kp){
  kf[0]=*(const __attribute__((address_space(3))) bf16x8*)(kp);      kf[1]=*(const __attribute__((address_space(3))) bf16x8*)(kp+512);
  kf[2]=*(const __attribute__((address_space(3))) bf16x8*)(kp+2048); kf[3]=*(const __attribute__((address_space(3))) bf16x8*)(kp+2560);
  kf[4]=*(const __attribute__((address_space(3))) bf16x8*)(kp+4096); kf[5]=*(const __attribute__((address_space(3))) bf16x8*)(kp+4608);
  kf[6]=*(const __attribute__((address_space(3))) bf16x8*)(kp+6144); kf[7]=*(const __attribute__((address_space(3))) bf16x8*)(kp+6656);
}
__device__ __forceinline__ void kload2(bf16x8*kf,lds_cptr kp,int j){ kf[2*j]=*(const __attribute__((address_space(3))) bf16x8*)(kp+j*2048); kf[2*j+1]=*(const __attribute__((address_space(3))) bf16x8*)(kp+j*2048+512); }
__device__ __forceinline__ s16x4 vtr(lds_cptr p){ return __builtin_bit_cast(s16x4,__builtin_amdgcn_ds_read_tr16_b64_v4i16((__attribute__((address_space(3))) v4i16_t*)p)); }
__device__ __forceinline__ float rowmax(const f32x16&p0,const f32x16&p1){
  float a=max3f(p0[0],p0[1],p1[0]),b=max3f(p0[2],p0[3],p1[1]);a=max3f(a,p1[2],p1[3]);
  #pragma unroll
  for(int r=4;r<16;r+=4){a=max3f(a,p0[r],p0[r+1]);b=max3f(b,p0[r+2],p0[r+3]);a=max3f(a,p1[r],p1[r+1]);b=max3f(b,p1[r+2],p1[r+3]);}
  const float m=max2f(a,b);
  auto rr=__builtin_amdgcn_permlane32_swap(__float_as_uint(m),__float_as_uint(m),false,false);
  return max2f(__uint_as_float(rr[0]),__uint_as_float(rr[1]));
}
__device__ __forceinline__ void pv(f32x16*o,int vb,bf16x8 pa0,bf16x8 pa1,bf16x8 pa2,bf16x8 pa3){
  #pragma unroll
  for(int d0=0;d0<2;++d0){s16x4 lo[4],hi[4];
    #pragma unroll
    for(int ks=0;ks<4;++ks){
      asm volatile("ds_read_b64_tr_b16 %0,%1 offset:%c2":"=&v"(lo[ks]):"v"(vb),"i"(d0*4096+ks*1024):"memory");
      asm volatile("ds_read_b64_tr_b16 %0,%1 offset:%c2":"=&v"(hi[ks]):"v"(vb),"i"(d0*4096+ks*1024+512):"memory");}
    asm volatile("s_waitcnt lgkmcnt(0)":::"memory");SBAR();
    #define PK(k) (bf16x8){lo[k][0],lo[k][1],lo[k][2],lo[k][3],hi[k][0],hi[k][1],hi[k][2],hi[k][3]}
    o[d0]=__builtin_amdgcn_mfma_f32_32x32x16_bf16(pa0,PK(0),o[d0],0,0,0);
    o[d0]=__builtin_amdgcn_mfma_f32_32x32x16_bf16(pa1,PK(1),o[d0],0,0,0);
    o[d0]=__builtin_amdgcn_mfma_f32_32x32x16_bf16(pa2,PK(2),o[d0],0,0,0);
    o[d0]=__builtin_amdgcn_mfma_f32_32x32x16_bf16(pa3,PK(3),o[d0],0,0,0);
    #undef PK
  }
}

#ifndef ATTN_STORE16
#define ATTN_STORE16(p,v) (*(u32x4*)(p)=(v))
#endif
template<int THRL,bool FIXM> __device__ __forceinline__ void attn_unit(int b,int h,int qb,const bf16*Q,const bf16*K,const bf16*V,bf16*O,float*SSQ,char*shm,const int tid,const float mfix){
  const int lane=tid&63,r32=lane&31,hi=lane>>5; const int wid=__builtin_amdgcn_readfirstlane(tid>>6);
  const long rowbase=(long)b*SEQ; const int q0=qb*QB;
  const bf16*Qw=Q+(rowbase+q0+wid*QBLK)*QP+h*D;
  const bf16*Kh=K+rowbase*KP+(h>>2)*D,*Vh=V+rowbase*VP+(h>>2)*D;
  const unsigned lds0=(unsigned)(uintptr_t)shm;
  float*wsf=(float*)(shm+LDS_WS)+wid*64;
  const bf16*ksrc=Kh+(long)lane*KP+wid*8;
  const bf16*vsrc=Vh+(long)(16*(wid&3)+(lane>>2))*VP+(wid>>2)*32+(lane&3)*8;
  const unsigned kdst=lds0+LDS_K+wid*1024, vdst=lds0+LDS_V+wid*1024;
  #define DMA_K(t,slot) glds16(ksrc+(long)(t)*KVBLK*KP,(unsigned)__builtin_amdgcn_readfirstlane(kdst+(slot)))
  #define DMA_V(t,slot) glds16(vsrc+(long)(t)*KVBLK*VP,(unsigned)__builtin_amdgcn_readfirstlane(vdst+(slot)))
  const int vb0=(int)(lds0+LDS_V)+((lane>>4)&1)*32+(lane&3)*8+(4*hi+((lane&15)>>2))*64;
  const char*Kbase=shm+LDS_K; bf16x8 kf[8];
  const lds_cptr shm3=(lds_cptr)shm; const lds_cptr kp0=shm3+LDS_K+hi*1024+r32*16; const lds_cptr vp0=shm3+LDS_V+((lane>>4)&1)*32+(lane&3)*8+(4*hi+((lane&15)>>2))*64;
  constexpr int NT=SEQ/KVBLK;
  DMA_K(0,0);DMA_V(0,0);DMA_K(1,SLOTB);
  bf16x8 qr[4];
  #pragma unroll
  for(int d0=0;d0<4;++d0)qr[d0]=*reinterpret_cast<const bf16x8*>(&Qw[(long)r32*QP+d0*16+hi*8]);
  float mhat=0.f,l_reg=0.f;f32x16 o[2];o[0]=f32x16{};o[1]=f32x16{};f32x16 negm=f32x16{};
  if constexpr(!FIXM) asm volatile("":"+v"(negm));
  const int qrel=wid*QBLK+r32;(void)qrel;
  #define CMASK(P0,P1,t) do{}while(0)
  bool resc=false;
  #define START(P0,P1) do{ if constexpr(!FIXM){ const float rm=rowmax(P0,P1); resc=false; \
    { const float dl=rm; mhat=fadd_s(mhat,dl); \
      _Pragma("unroll") for(int r=0;r<16;++r){P0[r]=fsub_s(P0[r],dl);P1[r]=fsub_s(P1[r],dl);} \
      _Pragma("unroll") for(int r=0;r<16;++r)negm[r]=-mhat; asm volatile("":"+v"(negm)); } } \
    _Pragma("unroll") for(int r=0;r<16;++r)P0[r]=__builtin_amdgcn_exp2f(P0[r]); }while(0)
  #define RESC() do{ if constexpr(!FIXM) if(resc){ asm volatile("s_waitcnt lgkmcnt(0)":::"memory"); \
      _Pragma("unroll") for(int d_=0;d_<2;++d_) _Pragma("unroll") for(int r=0;r<16;++r)o[d_][r]*=wsf[crow(r,hi)]; } }while(0)
  f32x16 pA0,pA1,pB0,pB1;
  int sl_prev=0,sl_cur=0,sl_next=SLOTB;
  #define ROT() do{sl_prev=sl_cur;sl_cur=sl_next;sl_next=(sl_next==(NSLOT-1)*SLOTB)?0:sl_next+SLOTB;}while(0)
  DMA_K(2,2*SLOTB);
  WAIT_BAR(3);
  qkt(pA0,pA1,Kbase,qr,negm,r32,hi);asm volatile("s_nop 15\n\ts_nop 7":"+v"(pA0),"+v"(pA1));CMASK(pA0,pA1,0);
  START(pA0,pA1);
  _Pragma("unroll") for(int r=0;r<16;++r)pA1[r]=__builtin_amdgcn_exp2f(pA1[r]);
  WAIT_BAR(0);
  DMA_K(3,0);DMA_V(1,SLOTB);
  ROT();
  kload8(kf,kp0+sl_cur);
  WAIT_BAR(2);
  s16x4 vlo[8],vhi[8]; u32x4 pw0,pw1,pw2,pw3;
  #define PKW(P,B) cvtpk_s(P[B],P[B+1])
  #define PAF(k) __builtin_bit_cast(bf16x8,pw##k)
  #define VFR(i) (bf16x8){vlo[i][0],vlo[i][1],vlo[i][2],vlo[i][3],vhi[i][0],vhi[i][1],vhi[i][2],vhi[i][3]}
  #define PIN(x) asm volatile("":"+v"(x))
  #define MX3(a,b,c) __builtin_fmaxf(__builtin_fmaxf((a),(b)),(c))
  #define GAPA(MF,A0,A1,A2,A3,W0,W1,PW) do{ MF; sacc+=A0; sacc+=A1; sacc+=A2; sacc+=A3; PIN(sacc); W0; W1; PIN(PW); SBAR(); }while(0)
  #define EX(v) __builtin_amdgcn_exp2f(v)
  #define GAPB(MF,X,B) do{ MF; X[B]=EX(X[B]); X[B+1]=EX(X[B+1]); X[B+2]=EX(X[B+2]); X[B+3]=EX(X[B+3]); PIN(X); SBAR(); }while(0)
  #define VRD(i) do{ vlo[i]=vtr(vp_+(((i)>>2)*4096+((i)&3)*1024)); vhi[i]=vtr(vp_+(((i)>>2)*4096+((i)&3)*1024+512)); }while(0)
  #define KRD(G,j) do{ if(G){ kload2(kf,kp0+sl_next,j); SBAR(); } }while(0)
  #define STEP(C0,C1,P0,P1,t,GK,GV,GL) do{ SBAR(); \
    const lds_cptr vp_=vp0+sl_prev; \
    VRD(0); SBAR(); float sacc=(P0[0]+P0[1]); \
    GAPA(C0=__builtin_amdgcn_mfma_f32_32x32x16_bf16(kf[0],qr[0],negm,0,0,0), P0[2],P0[3],P0[4],P0[5],     pw0[0]=PKW(P0,0), pw0[1]=PKW(P0,2), pw0); \
    VRD(4); SBAR(); GAPA(C1=__builtin_amdgcn_mfma_f32_32x32x16_bf16(kf[1],qr[0],negm,0,0,0), P0[6],P0[7],P0[8],P0[9],     pw0[2]=PKW(P0,4), pw0[3]=PKW(P0,6), pw0); \
    VRD(1); SBAR(); GAPA(C0=__builtin_amdgcn_mfma_f32_32x32x16_bf16(kf[2],qr[1],C0,0,0,0),   P0[10],P0[11],P0[12],P0[13], pw1[0]=PKW(P0,8), pw1[1]=PKW(P0,10), pw1); \
    VRD(5); SBAR(); GAPA(C1=__builtin_amdgcn_mfma_f32_32x32x16_bf16(kf[3],qr[1],C1,0,0,0),   P0[14],P0[15],P1[0],P1[1],   pw1[2]=PKW(P0,12),pw1[3]=PKW(P0,14), pw1); \
    VRD(2); SBAR(); GAPA(C0=__builtin_amdgcn_mfma_f32_32x32x16_bf16(kf[4],qr[2],C0,0,0,0),   P1[2],P1[3],P1[4],P1[5],     pw2[0]=PKW(P1,0), pw2[1]=PKW(P1,2), pw2); \
    VRD(6); SBAR(); GAPA(C1=__builtin_amdgcn_mfma_f32_32x32x16_bf16(kf[5],qr[2],C1,0,0,0),   P1[6],P1[7],P1[8],P1[9],     pw2[2]=PKW(P1,4), pw2[3]=PKW(P1,6), pw2); \
    VRD(3); SBAR(); GAPA(C0=__builtin_amdgcn_mfma_f32_32x32x16_bf16(kf[6],qr[3],C0,0,0,0),   P1[10],P1[11],P1[12],P1[13], pw3[0]=PKW(P1,8), pw3[1]=PKW(P1,10), pw3); \
    VRD(7); SBAR(); GAPA(C1=__builtin_amdgcn_mfma_f32_32x32x16_bf16(kf[7],qr[3],C1,0,0,0),   P1[14],P1[15],0.f,0.f,       pw3[2]=PKW(P1,12),pw3[3]=PKW(P1,14), pw3); \
    l_reg+=sacc; \
    if(GK){DMA_K((t)+3,sl_cur);} if(GV){DMA_V((t)+1,sl_next);} \
    CMASK(C0,C1,t); \
    if constexpr(!FIXM){ float a=MX3(C0[0],C0[1],C1[0]),b=MX3(C0[2],C0[3],C1[1]); a=MX3(a,C1[2],C1[3]); \
      _Pragma("unroll") for(int r=4;r<16;r+=4){a=MX3(a,C0[r],C0[r+1]);b=MX3(b,C0[r+2],C0[r+3]);a=MX3(a,C1[r],C1[r+1]);b=MX3(b,C1[r+2],C1[r+3]);} \
      float rm=__builtin_fmaxf(a,b); { auto rr=__builtin_amdgcn_permlane32_swap(__float_as_uint(rm),__float_as_uint(rm),false,false); rm=__builtin_fmaxf(__uint_as_float(rr[0]),__uint_as_float(rr[1])); } \
      resc=false; \
      if(__builtin_expect(__any(rm>(float)THRL),0)){ const float dl=__builtin_fmaxf(rm,0.f); mhat+=dl; \
        _Pragma("unroll") for(int r=0;r<16;++r){C0[r]-=dl;C1[r]-=dl;} \
        _Pragma("unroll") for(int r=0;r<16;++r)negm[r]=-mhat; asm volatile("":"+v"(negm)); \
        const float f=__builtin_amdgcn_exp2f(-dl); l_reg*=f; if(hi==0)wsf[r32]=f; resc=true; } } \
    SBAR(); \
    GAPB(o[0]=__builtin_amdgcn_mfma_f32_32x32x16_bf16(PAF(0),VFR(0),o[0],0,0,0), C0,0); \
    GAPB(o[1]=__builtin_amdgcn_mfma_f32_32x32x16_bf16(PAF(0),VFR(4),o[1],0,0,0), C0,4); \
    KRD(GL,0); GAPB(o[0]=__builtin_amdgcn_mfma_f32_32x32x16_bf16(PAF(1),VFR(1),o[0],0,0,0), C0,8); \
    KRD(GL,1); GAPB(o[1]=__builtin_amdgcn_mfma_f32_32x32x16_bf16(PAF(1),VFR(5),o[1],0,0,0), C0,12); \
    KRD(GL,2); GAPB(o[0]=__builtin_amdgcn_mfma_f32_32x32x16_bf16(PAF(2),VFR(2),o[0],0,0,0), C1,0); \
    KRD(GL,3); GAPB(o[1]=__builtin_amdgcn_mfma_f32_32x32x16_bf16(PAF(2),VFR(6),o[1],0,0,0), C1,4); \
    GAPB(o[0]=__builtin_amdgcn_mfma_f32_32x32x16_bf16(PAF(3),VFR(3),o[0],0,0,0), C1,8); \
    GAPB(o[1]=__builtin_amdgcn_mfma_f32_32x32x16_bf16(PAF(3),VFR(7),o[1],0,0,0), C1,12); \
    }while(0)
  int t=1;
  #undef CMASK
  #define CMASK(P0,P1,t) do{}while(0)
  for(;t+5<NT;t+=2){
    STEP(pB0,pB1,pA0,pA1,t,true,true,true);     WAIT_BAR(2); RESC(); ROT();
    STEP(pA0,pA1,pB0,pB1,t+1,true,true,true);   WAIT_BAR(2); RESC(); ROT();
  }
  #undef CMASK
  #define CMASK(P0,P1,t) do{}while(0)
  #define ENDW(tt) do{ if((tt)+3<NT){WAIT_BAR(2);} else if((tt)+2<NT){WAIT_BAR(1);} else {WAIT_BAR(0);} }while(0)
  for(;t+1<NT;t+=2){
    STEP(pB0,pB1,pA0,pA1,t,(t+3<NT),(t+1<NT),(t+1<NT));       ENDW(t);   RESC(); ROT();
    STEP(pA0,pA1,pB0,pB1,t+1,(t+4<NT),(t+2<NT),(t+2<NT));     ENDW(t+1); RESC(); ROT();
  }
  STEP(pB0,pB1,pA0,pA1,NT-1,false,false,false); RESC();
  { float sacc=pB0[0]+pB0[1]; _Pragma("unroll") for(int r=2;r<16;++r)sacc+=pB0[r]; _Pragma("unroll") for(int r=0;r<16;++r)sacc+=pB1[r]; l_reg+=sacc;
    pw0=(u32x4){PKW(pB0,0),PKW(pB0,2),PKW(pB0,4),PKW(pB0,6)};pw1=(u32x4){PKW(pB0,8),PKW(pB0,10),PKW(pB0,12),PKW(pB0,14)};pw2=(u32x4){PKW(pB1,0),PKW(pB1,2),PKW(pB1,4),PKW(pB1,6)};pw3=(u32x4){PKW(pB1,8),PKW(pB1,10),PKW(pB1,12),PKW(pB1,14)};
    SBAR(); pv(o,vb0+sl_cur,PAF(0),PAF(1),PAF(2),PAF(3)); }
  #undef PKW
  #undef PAF
  #undef VFR
  #undef PIN
  #undef MX3
  #undef GAPA
  #undef GAPB
  #undef EX
  #undef VRD
  #undef KRD
  #undef STEP
  #undef ENDW
  {auto rr=__builtin_amdgcn_permlane32_swap(__float_as_uint(l_reg),__float_as_uint(l_reg),false,false);l_reg=__uint_as_float(rr[0])+__uint_as_float(rr[1]);}
  if(hi==0)wsf[32+r32]=l_reg;asm volatile("s_waitcnt lgkmcnt(0)":::"memory");
  float rli[16];
  #pragma unroll
  for(int r=0;r<16;++r)rli[r]=__builtin_amdgcn_rcpf(wsf[32+crow(r,hi)]);
  bf16*Ow=O+(rowbase+q0+wid*QBLK)*OP+h*D;
  { bf16*stg=(bf16*)(shm+LDS_OST)+wid*2048;
    #pragma unroll
    for(int r=0;r<16;++r){const int orow=crow(r,hi);
      #pragma unroll
      for(int d0=0;d0<2;++d0)stg[orow*64+d0*32+r32]=(bf16)f2bf(o[d0][r]*rli[r]);}
    asm volatile("s_waitcnt lgkmcnt(0)":::"memory");
    #pragma unroll
    for(int i=0;i<4;++i){const int row=i*8+(lane>>3),ch=lane&7; const u32x4 v=*(const u32x4*)(stg+row*64+ch*8); ATTN_STORE16(Ow+(long)row*OP+ch*8,v);
      if(SSQ){ const unsigned w_[4]={v.x,v.y,v.z,v.w}; float s_=0.f;
        #pragma unroll
        for(int k=0;k<4;++k){const float a_=__uint_as_float(w_[k]<<16),b_=__uint_as_float(w_[k]&0xffff0000u);s_+=a_*a_+b_*b_;}
        s_+=__shfl_xor(s_,1);s_+=__shfl_xor(s_,2);s_+=__shfl_xor(s_,4);
        if(ch==0)SSQ[(rowbase+q0+wid*QBLK+row)*NHEAD+h]=s_; } } }
  asm volatile("s_waitcnt lgkmcnt(0)\n\ts_barrier":::"memory");
  #undef DMA_K
  #undef DMA_V
  #undef CMASK
  #undef START
  #undef RESC
  #undef ROT
}

namespace fx { constexpr int NSK=4, NSV=3, LDS_K=0, LDS_V=NSK*SLOTB, LDS_WS=LDS_V+NSV*SLOTB, LDS_OST=LDS_WS+NW*64*4, LDS_BYTES=LDS_OST+NW*4096; }
__device__ __forceinline__ void attn_unit_fx(int b,int h,int qb,const bf16*Q,const bf16*K,const bf16*V,bf16*O,float*SSQ,char*shm,const int tid,const float mfix){
  const int lane=tid&63,r32=lane&31,hi=lane>>5; const int wid=__builtin_amdgcn_readfirstlane(tid>>6);
  const long rowbase=(long)b*SEQ; const int q0=qb*QB;
  const bf16*Qw=Q+(rowbase+q0+wid*QBLK)*QP+h*D;
  const bf16*Kh=K+rowbase*KP+(h>>2)*D,*Vh=V+rowbase*VP+(h>>2)*D;
  const unsigned lds0=(unsigned)(uintptr_t)shm;
  float*wsf=(float*)(shm+fx::LDS_WS)+wid*64;
  const bf16*ksrc=Kh+(long)lane*KP+wid*8;
  const bf16*vsrc=Vh+(long)(16*(wid&3)+(lane>>2))*VP+(wid>>2)*32+(lane&3)*8;
  const unsigned kdst=lds0+fx::LDS_K+wid*1024, vdst=lds0+fx::LDS_V+wid*1024;
  #define DMA_K(t,slot) glds16(ksrc+(long)(t)*KVBLK*KP,(unsigned)__builtin_amdgcn_readfirstlane(kdst+(slot)))
  #define DMA_V(t,slot) glds16(vsrc+(long)(t)*KVBLK*VP,(unsigned)__builtin_amdgcn_readfirstlane(vdst+(slot)))
  const int vb0=(int)(lds0+fx::LDS_V)+((lane>>4)&1)*32+(lane&3)*8+(4*hi+((lane&15)>>2))*64;
  const char*Kbase=shm+fx::LDS_K; bf16x8 kf[8];
  const lds_cptr shm3=(lds_cptr)shm; const lds_cptr kp0=shm3+fx::LDS_K+hi*1024+r32*16; const lds_cptr vp0=shm3+fx::LDS_V+((lane>>4)&1)*32+(lane&3)*8+(4*hi+((lane&15)>>2))*64;
  constexpr int NT=SEQ/KVBLK;
  DMA_K(0,0);DMA_V(0,0);DMA_K(1,SLOTB);
  bf16x8 qr[4];
  #pragma unroll
  for(int d0=0;d0<4;++d0)qr[d0]=*reinterpret_cast<const bf16x8*>(&Qw[(long)r32*QP+d0*16+hi*8]);
  float l_reg=0.f;f32x16 o[2];o[0]=f32x16{};o[1]=f32x16{};
  const f32x16 negm=f32x16{};
  f32x16 pA0,pA1,pB0,pB1;
  DMA_K(2,2*SLOTB);
  WAIT_BAR(3);
  qkt(pA0,pA1,Kbase,qr,negm,r32,hi);asm volatile("s_nop 15\n\ts_nop 7":"+v"(pA0),"+v"(pA1));
  _Pragma("unroll") for(int r=0;r<16;++r)pA0[r]=__builtin_amdgcn_exp2f(pA0[r]);
  _Pragma("unroll") for(int r=0;r<16;++r)pA1[r]=__builtin_amdgcn_exp2f(pA1[r]);
  WAIT_BAR(0);
  DMA_K(3,3*SLOTB);DMA_V(1,SLOTB);
  kload8(kf,kp0+SLOTB);
  s16x4 vlo[8],vhi[8]; u32x4 pw0,pw1,pw2,pw3;
  #define PKW(P,B) cvtpk_s(P[B],P[B+1])
  #define PAF(k) __builtin_bit_cast(bf16x8,pw##k)
  #define VFR(i) (bf16x8){vlo[i][0],vlo[i][1],vlo[i][2],vlo[i][3],vhi[i][0],vhi[i][1],vhi[i][2],vhi[i][3]}
  #define PIN(x) asm volatile("":"+v"(x))
  #define GAPA(MF,A0,A1,A2,A3,W0,W1,PW) do{ MF; sacc+=A0; sacc+=A1; sacc+=A2; sacc+=A3; PIN(sacc); W0; W1; PIN(PW); SBAR(); }while(0)
  #define EX(v) __builtin_amdgcn_exp2f(v)
  #define GAPB(MF,X,B) do{ MF; X[B]=EX(X[B]); X[B+1]=EX(X[B+1]); X[B+2]=EX(X[B+2]); X[B+3]=EX(X[B+3]); PIN(X); SBAR(); }while(0)
  #define VRD(i) do{ vlo[i]=vtr(vp_+(((i)>>2)*4096+((i)&3)*1024)); vhi[i]=vtr(vp_+(((i)>>2)*4096+((i)&3)*1024+512)); }while(0)
  #define KRD(G,j,KS) do{ if(G){ kload2(kf,kp0+(KS),j); SBAR(); } }while(0)
  #define PHA(C0,C1,P0,P1,VS) do{ SBAR(); \
    const lds_cptr vp_=vp0+(VS); \
    VRD(0); SBAR(); float sacc=(P0[0]+P0[1]); \
    GAPA(C0=__builtin_amdgcn_mfma_f32_32x32x16_bf16(kf[0],qr[0],negm,0,0,0), P0[2],P0[3],P0[4],P0[5],     pw0[0]=PKW(P0,0), pw0[1]=PKW(P0,2), pw0); \
    VRD(4); SBAR(); GAPA(C1=__builtin_amdgcn_mfma_f32_32x32x16_bf16(kf[1],qr[0],negm,0,0,0), P0[6],P0[7],P0[8],P0[9],     pw0[2]=PKW(P0,4), pw0[3]=PKW(P0,6), pw0); \
    VRD(1); SBAR(); GAPA(C0=__builtin_amdgcn_mfma_f32_32x32x16_bf16(kf[2],qr[1],C0,0,0,0),   P0[10],P0[11],P0[12],P0[13], pw1[0]=PKW(P0,8), pw1[1]=PKW(P0,10), pw1); \
    VRD(5); SBAR(); GAPA(C1=__builtin_amdgcn_mfma_f32_32x32x16_bf16(kf[3],qr[1],C1,0,0,0),   P0[14],P0[15],P1[0],P1[1],   pw1[2]=PKW(P0,12),pw1[3]=PKW(P0,14), pw1); \
    VRD(2); SBAR(); GAPA(C0=__builtin_amdgcn_mfma_f32_32x32x16_bf16(kf[4],qr[2],C0,0,0,0),   P1[2],P1[3],P1[4],P1[5],     pw2[0]=PKW(P1,0), pw2[1]=PKW(P1,2), pw2); \
    VRD(6); SBAR(); GAPA(C1=__builtin_amdgcn_mfma_f32_32x32x16_bf16(kf[5],qr[2],C1,0,0,0),   P1[6],P1[7],P1[8],P1[9],     pw2[2]=PKW(P1,4), pw2[3]=PKW(P1,6), pw2); \
    VRD(3); SBAR(); GAPA(C0=__builtin_amdgcn_mfma_f32_32x32x16_bf16(kf[6],qr[3],C0,0,0,0),   P1[10],P1[11],P1[12],P1[13], pw3[0]=PKW(P1,8), pw3[1]=PKW(P1,10), pw3); \
    VRD(7); SBAR(); GAPA(C1=__builtin_amdgcn_mfma_f32_32x32x16_bf16(kf[7],qr[3],C1,0,0,0),   P1[14],P1[15],0.f,0.f,       pw3[2]=PKW(P1,12),pw3[3]=PKW(P1,14), pw3); \
    l_reg+=sacc; SBAR(); }while(0)
  #define PHB(C0,C1,KS,GL) do{ SBAR(); \
    GAPB(o[0]=__builtin_amdgcn_mfma_f32_32x32x16_bf16(PAF(0),VFR(0),o[0],0,0,0), C0,0); \
    GAPB(o[1]=__builtin_amdgcn_mfma_f32_32x32x16_bf16(PAF(0),VFR(4),o[1],0,0,0), C0,4); \
    KRD(GL,0,KS); GAPB(o[0]=__builtin_amdgcn_mfma_f32_32x32x16_bf16(PAF(1),VFR(1),o[0],0,0,0), C0,8); \
    KRD(GL,1,KS); GAPB(o[1]=__builtin_amdgcn_mfma_f32_32x32x16_bf16(PAF(1),VFR(5),o[1],0,0,0), C0,12); \
    KRD(GL,2,KS); GAPB(o[0]=__builtin_amdgcn_mfma_f32_32x32x16_bf16(PAF(2),VFR(2),o[0],0,0,0), C1,0); \
    KRD(GL,3,KS); GAPB(o[1]=__builtin_amdgcn_mfma_f32_32x32x16_bf16(PAF(2),VFR(6),o[1],0,0,0), C1,4); \
    GAPB(o[0]=__builtin_amdgcn_mfma_f32_32x32x16_bf16(PAF(3),VFR(3),o[0],0,0,0), C1,8); \
    GAPB(o[1]=__builtin_amdgcn_mfma_f32_32x32x16_bf16(PAF(3),VFR(7),o[1],0,0,0), C1,12); \
    }while(0)
  #define DMAS(t,GK,GV) do{ if(GK){DMA_K((t)+3,kd);} if(GV){DMA_V((t)+1,vd);} }while(0)
  #define ENDW(t) do{ if((t)+3<NT){WAIT_BAR(2);} else if((t)+1<NT){WAIT_BAR(1);} else {WAIT_BAR(0);} }while(0)
  #define ROTS() do{ kn=(kn+SLOTB)&(fx::NSK*SLOTB-1); kd=(kd+SLOTB)&(fx::NSK*SLOTB-1); vp=(vp==2*SLOTB)?0:vp+SLOTB; vd=(vd==2*SLOTB)?0:vd+SLOTB; }while(0)
  int vlast;
  if(wid<4){
    int kn=2*SLOTB,kd=0,vp=0,vd=2*SLOTB;
    int t=1;
    for(;t+5<NT;t+=2){
      PHA(pB0,pB1,pA0,pA1,vp); DMAS(t,true,true);   PHB(pB0,pB1,kn,true); WAIT_BAR(2); ROTS();
      PHA(pA0,pA1,pB0,pB1,vp); DMAS(t+1,true,true); PHB(pA0,pA1,kn,true); WAIT_BAR(2); ROTS();
    }
    for(;t+1<NT;t+=2){
      PHA(pB0,pB1,pA0,pA1,vp); DMAS(t,(t+3<NT),(t+1<NT));   PHB(pB0,pB1,kn,(t+1<NT)); ENDW(t);   ROTS();
      PHA(pA0,pA1,pB0,pB1,vp); DMAS(t+1,(t+4<NT),(t+2<NT)); PHB(pA0,pA1,kn,(t+2<NT)); ENDW(t+1); ROTS();
    }
    PHA(pB0,pB1,pA0,pA1,vp); PHB(pB0,pB1,kn,false); WAIT_BAR(0); ROTS();
    vlast=vp;
  } else {
    int kn=2*SLOTB,kd=0,vp=0,vd=2*SLOTB;
    PHA(pB0,pB1,pA0,pA1,vp); DMAS(1,true,true); WAIT_BAR(2);
    kd=SLOTB; vp=SLOTB; vd=0;
    int t=2;
    for(;t+5<NT;t+=2){
      PHB(pB0,pB1,kn,true); DMAS(t,true,true);   PHA(pA0,pA1,pB0,pB1,vp); WAIT_BAR(2); ROTS();
      PHB(pA0,pA1,kn,true); DMAS(t+1,true,true); PHA(pB0,pB1,pA0,pA1,vp); WAIT_BAR(2); ROTS();
    }
    for(;t+1<NT;t+=2){
      PHB(pB0,pB1,kn,true); DMAS(t,(t+3<NT),(t+1<NT));   PHA(pA0,pA1,pB0,pB1,vp); ENDW(t);   ROTS();
      PHB(pA0,pA1,kn,true); DMAS(t+1,(t+4<NT),(t+2<NT)); PHA(pB0,pB1,pA0,pA1,vp); ENDW(t+1); ROTS();
    }
    PHB(pB0,pB1,kn,false);
    vlast=vp;
  }
  { float sacc=pB0[0]+pB0[1]; _Pragma("unroll") for(int r=2;r<16;++r)sacc+=pB0[r]; _Pragma("unroll") for(int r=0;r<16;++r)sacc+=pB1[r]; l_reg+=sacc;
    pw0=(u32x4){PKW(pB0,0),PKW(pB0,2),PKW(pB0,4),PKW(pB0,6)};pw1=(u32x4){PKW(pB0,8),PKW(pB0,10),PKW(pB0,12),PKW(pB0,14)};pw2=(u32x4){PKW(pB1,0),PKW(pB1,2),PKW(pB1,4),PKW(pB1,6)};pw3=(u32x4){PKW(pB1,8),PKW(pB1,10),PKW(pB1,12),PKW(pB1,14)};
    SBAR(); pv(o,vb0+vlast,PAF(0),PAF(1),PAF(2),PAF(3)); }
  #undef PKW
  #undef PAF
  #undef VFR
  #undef PIN
  #undef GAPA
  #undef GAPB
  #undef EX
  #undef VRD
  #undef KRD
  #undef PHA
  #undef PHB
  #undef DMAS
  #undef ENDW
  #undef ROTS
  {auto rr=__builtin_amdgcn_permlane32_swap(__float_as_uint(l_reg),__float_as_uint(l_reg),false,false);l_reg=__uint_as_float(rr[0])+__uint_as_float(rr[1]);}
  int lane_e=__lane_id(); asm volatile("":"+v"(lane_e));
  { const int lane=lane_e,r32=lane&31,hi=lane>>5;
  if(hi==0)wsf[32+r32]=l_reg;asm volatile("s_waitcnt lgkmcnt(0)":::"memory");
  float rli[16];
  #pragma unroll
  for(int r=0;r<16;++r)rli[r]=__builtin_amdgcn_rcpf(wsf[32+crow(r,hi)]);
  bf16*Ow=O+(rowbase+q0+wid*QBLK)*OP+h*D;
  { bf16*stg=(bf16*)(shm+fx::LDS_OST)+wid*2048;
    #pragma unroll
    for(int r=0;r<16;++r){const int orow=crow(r,hi);
      #pragma unroll
      for(int d0=0;d0<2;++d0)stg[orow*64+d0*32+r32]=(bf16)f2bf(o[d0][r]*rli[r]);}
    asm volatile("s_waitcnt lgkmcnt(0)":::"memory");
    #pragma unroll
    for(int i=0;i<4;++i){const int row=i*8+(lane>>3),ch=lane&7; const u32x4 v=*(const u32x4*)(stg+row*64+ch*8); ATTN_STORE16(Ow+(long)row*OP+ch*8,v);
      if(SSQ){ const unsigned w_[4]={v.x,v.y,v.z,v.w}; float s_=0.f;
        #pragma unroll
        for(int k=0;k<4;++k){const float a_=__uint_as_float(w_[k]<<16),b_=__uint_as_float(w_[k]&0xffff0000u);s_+=a_*a_+b_*b_;}
        s_+=__shfl_xor(s_,1);s_+=__shfl_xor(s_,2);s_+=__shfl_xor(s_,4);
        if(ch==0)SSQ[(rowbase+q0+wid*QBLK+row)*NHEAD+h]=s_; } } } }
  asm volatile("s_waitcnt lgkmcnt(0)\n\ts_barrier":::"memory");
  #undef DMA_K
  #undef DMA_V
}
constexpr int ATTN_LDS_BYTES=LDS_BYTES;
struct AttnTensors { const bf16* Q; const bf16* K; const bf16* V; bf16* O; float* SSQ; };
struct AttnUnit { int bh; int qb; };
template<int THRL=8> __device__ __forceinline__ void attn_phase(char*lds,const AttnTensors&T,const unsigned*qkmax,int grid,int block,const int tid){
  const int nunits=BATCH*NHEAD*NQB;
  const int vcu=(grid%8==0)?(block%8)*(grid/8)+block/8:block;
  const int per=(nunits+grid-1)/grid;
  float q2=0.f,k2=0.f;
  for(int i=tid;i<grid*8;i+=512){ const float2 v=*(const float2*)(qkmax+2*i); q2=fmaxf(q2,v.x); k2=fmaxf(k2,v.y); }
  #pragma unroll
  for(int o=1;o<64;o<<=1){ q2=fmaxf(q2,__shfl_xor(q2,o)); k2=fmaxf(k2,__shfl_xor(k2,o)); }
  { float*red=(float*)(lds+98304); if((tid&63)==0){ red[(tid>>6)*2]=q2; red[(tid>>6)*2+1]=k2; } __syncthreads();
    #pragma unroll
    for(int w=0;w<8;++w){ q2=fmaxf(q2,red[2*w]); k2=fmaxf(k2,red[2*w+1]); } }
  const float mfix=sqrtf(q2*k2)*1.02f+0.01f;
  const bool fixm=__builtin_amdgcn_readfirstlane(mfix<=60.f?1:0)!=0;
  for(int i=0;i<per;++i){ const int u=vcu*per+i; if(u>=nunits)break; const int bh=u/NQB,qb=u%NQB;
    int tid_u=tid; asm volatile("":"+v"(tid_u));
    if(fixm) attn_unit<THRL,true>(bh/NHEAD,bh%NHEAD,qb,T.Q,T.K,T.V,T.O,T.SSQ,lds,tid_u,mfix);
    else attn_unit<THRL,false>(bh/NHEAD,bh%NHEAD,qb,T.Q,T.K,T.V,T.O,T.SSQ,lds,tid_u,0.f); }
}
#undef SBAR
#undef WAIT_BAR
}
namespace ssd {
typedef short v4i16_t __attribute__((ext_vector_type(4)));
__device__ __forceinline__ v4i16_t trr(LAS const unsigned char* p) { return __builtin_amdgcn_ds_read_tr16_b64_v4i16((LAS v4i16_t*)p); }
__device__ __forceinline__ bf16x8 cat8(v4i16_t lo, v4i16_t hi) { return (bf16x8){lo[0], lo[1], lo[2], lo[3], hi[0], hi[1], hi[2], hi[3]}; }
__device__ __forceinline__ float wave_incl_scan(float v, int lane) {
#pragma unroll
    for (int o = 1; o < 64; o <<= 1) { const float t = __shfl_up(v, o); if (lane >= o) v += t; }
    return v;
}
constexpr int BS = 272;
constexpr int XS = 144;
__device__ __forceinline__ void phase_a(LAS unsigned char* lds, const bf16_t* xbc, const float* dt, const float* a_log, bf16_t* stf, bf16_t* stb, float* decf, float* decb, int G, int bx, const int tid) {
    const int lane = tid & 63, wave = __builtin_amdgcn_readfirstlane(tid >> 6), g4 = lane >> 4, fr = lane & 15, q_ = fr >> 2, p_ = lane & 3;
    LAS unsigned char* Bimg = lds; LAS unsigned char* Ximg = lds + 34816;
    LAS float* dta = (LAS float*)(lds + 108544); LAS float* cum = (LAS float*)(lds + 110592); LAS float* tot = (LAS float*)(lds + 112640);
    constexpr int NU = BATCH * NCHUNK * 4;
    float dtv = 0.f; u32x4 Br[4], Xr[4];
#define SA_LOAD(U) do { const int bc_ = (U) >> 2, hp_ = (U) & 3, m0_ = bc_ * CHUNK; \
        dtv = dt[(size_t)(m0_ + (tid & 127)) * 16 + ((tid >> 7) & 1) * 8 + 2 * hp_ + (tid >> 8)]; \
        _Pragma("unroll") for (int i = 0; i < 4; ++i) { const int id = tid + i * 512; Br[i] = *(const u32x4*)(xbc + (size_t)(m0_ + (id >> 4)) * 1024 + 512 + (hp_ >> 1) * 128 + (id & 15) * 8); } \
        _Pragma("unroll") for (int i = 0; i < 4; ++i) { const int id = tid + i * 512, k_ = id >> 10, rid = id & 1023; Xr[i] = *(const u32x4*)(xbc + (size_t)(m0_ + (rid >> 3)) * 1024 + (2 * hp_ + k_) * 64 + (rid & 7) * 8); } } while (0)
    if (bx < NU) SA_LOAD(bx);
    for (int unit = bx; unit < NU; unit += G) {
        const int bc = unit >> 2, hp = unit & 3;
        const int qd = tid >> 7, kq = tid >> 8, dq = (tid >> 7) & 1;
        const float aq = -__expf(a_log[dq * 8 + 2 * hp + kq]);
        dta[qd * 128 + (tid & 127)] = dtv;
#pragma unroll
        for (int i = 0; i < 4; ++i) { const int id = tid + i * 512; *(LAS u32x4*)(Bimg + (id >> 4) * BS + (id & 15) * 16) = Br[i]; }
        __syncthreads();
        {
            const int s = tid & 127; const float x = dq ? dta[qd * 128 + 127 - s] : dta[qd * 128 + s];
            const float inc = wave_incl_scan(x, lane);
            if (lane == 63) tot[wave] = inc;
            __syncthreads();
            const float v = (inc + ((wave & 1) ? tot[wave - 1] : 0.f)) * aq;
            cum[qd * 128 + (dq ? 127 - s : s)] = v;
        }
        __syncthreads();
        {
#pragma unroll
            for (int i = 0; i < 4; ++i) { const int id = tid + i * 512, k = id >> 10, rid = id & 1023, row = rid >> 3, c16 = rid & 7;
                const u32x4 raw = Xr[i];
                const LAS float* cf = cum + (2 * k) * 128; const LAS float* cb_ = cum + (2 * k + 1) * 128;
                const float wf = __expf(cf[127] - cf[row]) * dta[(2 * k) * 128 + row], wb = __expf(cb_[0] - cb_[row]) * dta[(2 * k + 1) * 128 + row];
                const unsigned w[4] = {raw.x, raw.y, raw.z, raw.w}; unsigned pf[4], pb[4];
#pragma unroll
                for (int q = 0; q < 4; ++q) { const float lo = bf2f(w[q] & 0xffffu), hi = bf2f(w[q] >> 16); pf[q] = pk2(lo * wf, hi * wf); pb[q] = pk2(lo * wb, hi * wb); }
                *(LAS u32x4*)(Ximg + (2 * k) * 18432 + row * XS + c16 * 16) = (u32x4){pf[0], pf[1], pf[2], pf[3]}; *(LAS u32x4*)(Ximg + (2 * k + 1) * 18432 + row * XS + c16 * 16) = (u32x4){pb[0], pb[1], pb[2], pb[3]}; }
            if (tid < 2) { const int h = 2 * hp + tid; decf[bc * 8 + h] = __expf(cum[(2 * tid) * 128 + 127]); decb[bc * 8 + h] = __expf(cum[(2 * tid + 1) * 128]); }
        }
        __syncthreads();
        if (unit + G < NU) SA_LOAD(unit + G);
        const int k = wave >> 2, dir = (wave >> 1) & 1, pt0 = 2 * (wave & 1);
        LAS const unsigned char* Xd = Ximg + (2 * k + dir) * 18432;
        f32x4 acc[2][8];
#pragma unroll
        for (int t = 0; t < 2; ++t)
#pragma unroll
            for (int c = 0; c < 8; ++c) acc[t][c] = (f32x4){0.f, 0.f, 0.f, 0.f};
#pragma unroll
        for (int ks = 0; ks < 4; ++ks) {
            const int r0 = 32 * ks + 8 * g4 + q_;
            bf16x8 a[2];
#pragma unroll
            for (int t = 0; t < 2; ++t) a[t] = cat8(trr(Xd + r0 * XS + (16 * (pt0 + t) + 4 * p_) * 2), trr(Xd + (r0 + 4) * XS + (16 * (pt0 + t) + 4 * p_) * 2));
#pragma unroll
            for (int c = 0; c < 8; ++c) { const bf16x8 bq = cat8(trr(Bimg + r0 * BS + (16 * c + 4 * p_) * 2), trr(Bimg + (r0 + 4) * BS + (16 * c + 4 * p_) * 2));
#pragma unroll
                for (int t = 0; t < 2; ++t) acc[t][c] = __builtin_amdgcn_mfma_f32_16x16x32_bf16(a[t], bq, acc[t][c], 0, 0, 0); }
        }
        bf16_t* o = (dir ? stb : stf) + (size_t)(bc * 8 + 2 * hp + k) * 8192;
#pragma unroll
        for (int t = 0; t < 2; ++t)
#pragma unroll
            for (int c = 0; c < 8; ++c)
#pragma unroll
                for (int j = 0; j < 4; ++j) o[(16 * (pt0 + t) + 4 * g4 + j) * 128 + 16 * c + fr] = (bf16_t)f2bf(acc[t][c][j]);
        __syncthreads();
    }
#undef SA_LOAD
}
__device__ __forceinline__ void phase_b(LAS unsigned char* lds, const bf16_t* xbc, const bf16_t* proj, const float* dt, const float* a_log, const float* d_skip, const float* gain, const bf16_t* prevf, const bf16_t* prevb,
                                        bf16_t* mix, int G, int bx, const int tid) {
    const int lane = tid & 63, wave = __builtin_amdgcn_readfirstlane(tid >> 6), g4 = lane >> 4, fr = lane & 15, q_ = fr >> 2, p_ = lane & 3;
    LAS unsigned char* Bimg = lds; LAS unsigned char* Ximg = lds + 34816; LAS unsigned char* Pf = lds + 53248; LAS unsigned char* Pb = lds + 70656;
    LAS float* dtf = (LAS float*)(lds + 88064); LAS float* dtb = (LAS float*)(lds + 90112); LAS float* af = (LAS float*)(lds + 92160); LAS float* sb = (LAS float*)(lds + 94208);
    for (int unit = bx; unit < BATCH * NCHUNK * SG; unit += G) {
        const int bc = unit >> 1, grp = unit & 1, m0 = bc * CHUNK;
        const int q = 16 * wave + fr;
        { const int hl = tid >> 7, s = tid & 127; dtf[hl * 128 + s] = dt[(size_t)(m0 + s) * 16 + 4 * grp + hl]; dtb[hl * 128 + s] = dt[(size_t)(m0 + s) * 16 + 8 + 4 * grp + hl]; }
#pragma unroll
        for (int i = 0; i < 4; ++i) { const int id = tid + i * 512, row = id >> 4, c16 = id & 15; *(LAS u32x4*)(Bimg + row * BS + c16 * 16) = *(const u32x4*)(xbc + (size_t)(m0 + row) * 1024 + 512 + grp * 128 + c16 * 8); }
        u32x4 Xr[2], Fr[2], Rr[2];
#define SB_LOAD(HL) do { const int h_ = 4 * grp + (HL); const size_t uh_ = (size_t)(bc * 8 + h_) * 8192; \
            _Pragma("unroll") for (int i = 0; i < 2; ++i) { const int id = tid + i * 512; Xr[i] = *(const u32x4*)(xbc + (size_t)(m0 + (id >> 3)) * 1024 + h_ * 64 + (id & 7) * 8); \
                Fr[i] = *(const u32x4*)(prevf + uh_ + (id >> 4) * 128 + (id & 15) * 8); Rr[i] = *(const u32x4*)(prevb + uh_ + (id >> 4) * 128 + (id & 15) * 8); } } while (0)
        SB_LOAD(0);
        bf16x8 Cf[4];
#pragma unroll
        for (int ks = 0; ks < 4; ++ks) Cf[ks] = *(const bf16x8*)(xbc + (size_t)(m0 + q) * 1024 + 768 + grp * 128 + 32 * ks + 8 * g4);
        __syncthreads();
        { const int hl = tid >> 7, s = tid & 127, h = 4 * grp + hl; const float aF = -__expf(a_log[h]), aB = -__expf(a_log[8 + h]);
          LAS float* tot = sb + 512;
          const float incf = wave_incl_scan(dtf[hl * 128 + s], lane), incb = wave_incl_scan(dtb[hl * 128 + 127 - s], lane);
          if (lane == 63) { tot[wave * 2] = incf; tot[wave * 2 + 1] = incb; }
          __syncthreads();
          const bool hiw = (wave & 1) != 0;
          af[hl * 128 + s] = (incf + (hiw ? tot[(wave - 1) * 2] : 0.f)) * aF;
          sb[hl * 128 + 127 - s] = (incb + (hiw ? tot[(wave - 1) * 2 + 1] : 0.f)) * aB; }
        f32x4 cb[8];
#pragma unroll
        for (int si = 0; si < 8; ++si) { cb[si] = (f32x4){0.f, 0.f, 0.f, 0.f};
#pragma unroll
            for (int ks = 0; ks < 4; ++ks) { const bf16x8 a = *(LAS const bf16x8*)(Bimg + (16 * si + fr) * BS + (32 * ks + 8 * g4) * 2); cb[si] = __builtin_amdgcn_mfma_f32_16x16x32_bf16(a, Cf[ks], cb[si], 0, 0, 0); } }
        float ss = 0.f;
#pragma unroll 1
        for (int hl = 0; hl < 4; ++hl) {
            const int h = 4 * grp + hl;
            __syncthreads();
#pragma unroll
            for (int i = 0; i < 2; ++i) { const int id = tid + i * 512; *(LAS u32x4*)(Ximg + (id >> 3) * XS + (id & 7) * 16) = Xr[i];
                *(LAS u32x4*)(Pf + (id >> 4) * BS + (id & 15) * 16) = Fr[i]; *(LAS u32x4*)(Pb + (id >> 4) * BS + (id & 15) * 16) = Rr[i]; }
            __syncthreads();
            if (hl < 3) SB_LOAD(hl + 1);
            const bf16_t* zp = proj + (size_t)(m0 + q) * NPROJ_PAD + C_Z + h * 64 + 4 * g4;
            u32x2 znext = *(const u32x2*)zp;
            const float afq = af[hl * 128 + q], sbq = sb[hl * 128 + q];
            bf16x8 Mf[4];
#pragma unroll
            for (int i = 0; i < 4; ++i) { float mh[8];
#pragma unroll
                for (int half = 0; half < 2; ++half)
#pragma unroll
                    for (int e = 0; e < 4; ++e) { const int s = 32 * i + 16 * half + 4 * g4 + e;
                        const float wfv = dtf[hl * 128 + s] * __expf(fminf(afq - af[hl * 128 + s], 0.f)), wbv = dtb[hl * 128 + s] * __expf(fminf(sbq - sb[hl * 128 + s], 0.f));
                        const float wgt = (s <= q ? wfv : 0.f) + (s >= q ? wbv : 0.f);
                        mh[half * 4 + e] = cb[2 * i + half][e] * wgt; }
                u32x4 w; w.x = pk2(mh[0], mh[1]); w.y = pk2(mh[2], mh[3]); w.z = pk2(mh[4], mh[5]); w.w = pk2(mh[6], mh[7]); Mf[i] = __builtin_bit_cast(bf16x8, w); }
            const float ef = __expf(afq), eb = __expf(sbq), dsk = d_skip[h];
#pragma unroll 1
            for (int pt = 0; pt < 4; ++pt) {
                const u32x2 zr = znext; if (pt < 3) znext = *(const u32x2*)(zp + 16 * (pt + 1));
                f32x4 yd = (f32x4){0.f, 0.f, 0.f, 0.f}, yf = yd, yb = yd;
#pragma unroll
                for (int i = 0; i < 4; ++i) {
                    const int r0 = 32 * i + 4 * g4 + q_;
                    const bf16x8 a = cat8(trr(Ximg + r0 * XS + (16 * pt + 4 * p_) * 2), trr(Ximg + (r0 + 16) * XS + (16 * pt + 4 * p_) * 2));
                    yd = __builtin_amdgcn_mfma_f32_16x16x32_bf16(a, Mf[i], yd, 0, 0, 0); }
#pragma unroll
                for (int ks = 0; ks < 4; ++ks) {
                    const bf16x8 pa = *(LAS const bf16x8*)(Pf + (16 * pt + fr) * BS + (32 * ks + 8 * g4) * 2), pb = *(LAS const bf16x8*)(Pb + (16 * pt + fr) * BS + (32 * ks + 8 * g4) * 2);
                    yf = __builtin_amdgcn_mfma_f32_16x16x32_bf16(pa, Cf[ks], yf, 0, 0, 0); yb = __builtin_amdgcn_mfma_f32_16x16x32_bf16(pb, Cf[ks], yb, 0, 0, 0); }
                const u32x2 xr = *(LAS const u32x2*)(Ximg + q * XS + (16 * pt + 4 * g4) * 2);
                const float xq[4] = {bf2f(xr.x & 0xffffu), bf2f(xr.x >> 16), bf2f(xr.y & 0xffffu), bf2f(xr.y >> 16)};
                const float zq[4] = {bf2f(zr.x & 0xffffu), bf2f(zr.x >> 16), bf2f(zr.y & 0xffffu), bf2f(zr.y >> 16)};
                float yv[4];
#pragma unroll
                for (int j = 0; j < 4; ++j) { yv[j] = (yd[j] + ef * yf[j] + eb * yb[j] + xq[j] * dsk) * silu_f(zq[j]); ss += yv[j] * yv[j]; }
                u32x2 o; o.x = pk2(yv[0], yv[1]); o.y = pk2(yv[2], yv[3]);
                *(u32x2*)(mix + (size_t)(m0 + q) * D + 512 + grp * 256 + hl * 64 + 16 * pt + 4 * g4) = o;
            }
        }
#undef SB_LOAD
        ss += __shfl_xor(ss, 16); ss += __shfl_xor(ss, 32);
        const float rstd = 1.0f / sqrtf(ss * (1.f / 256.f) + EPS);
#pragma unroll 4
        for (int i = 0; i < 16; ++i) { const int col = grp * 256 + i * 16 + 4 * g4; const f32x4 gn = *(const f32x4*)(gain + col);
            u32x2* pp = (u32x2*)(mix + (size_t)(m0 + q) * D + 512 + col); const u32x2 r = *pp;
            u32x2 o; o.x = pk2(bf2f(r.x & 0xffffu) * rstd * gn.x, bf2f(r.x >> 16) * rstd * gn.y); o.y = pk2(bf2f(r.y & 0xffffu) * rstd * gn.z, bf2f(r.y >> 16) * rstd * gn.w);
            *pp = o; }
        __syncthreads();
    }
}
}
#ifndef REPEAT_PH
#define REPEAT_PH (-1)
#endif
#ifndef SSDB_IN_MEGA
#define SSDB_IN_MEGA true
#endif
constexpr int PH_PER_LAYER = 12, NPHASES = 1 + DEPTH * PH_PER_LAYER;
enum { K_RMS = 0, K_INPROJ, K_POST, K_SSDA, K_SCAN, K_MIXER, K_NORMS, K_OUTPROJ, K_ROUTER, K_GU, K_DOWN, K_COMBINE };
__global__ void __launch_bounds__(WG, 2) mega(Args args) {
    extern __shared__ __attribute__((aligned(16))) unsigned char lds_raw[];
    LAS unsigned char* lds = (LAS unsigned char*)lds_raw;
    volatile LAS unsigned* MISC = (volatile LAS unsigned*)(lds + MISC_OFF);
    {   const int tid0 = threadIdx.x;
        for (int u = tid0; u < (LDS_BYTES - LDSCTL_OFF) / 4; u += WG) ((LAS unsigned*)(lds + LDSCTL_OFF))[u] = 0u;
        __syncthreads(); }
    unsigned* barw = (unsigned*)(args.ws + WS_CTL) + CW_BAR + args.li * XCD_BAR_WORDS;
    (void)xcd_barrier_post(barw, MISC + 8);
    const int lo = args.ph_lo, hi = args.ph_hi;
    const int wave0 = __builtin_amdgcn_readfirstlane(threadIdx.x >> 6);
#define PH_BEGIN(phid) if (lo <= (phid) && (phid) < hi) { \
        int tid = wave0 * 64 + (int)__lane_id(); asm volatile("" : "+v"(tid)); int bx = blockIdx.x; asm volatile("" : "+s"(bx)); \
        const int lane = tid & 63, wave = __builtin_amdgcn_readfirstlane(tid >> 6); const int G = gridDim.x; \
        const int gw = bx * NWAVES + wave, nw = G * NWAVES, gt = bx * WG + tid, nt = G * WG; (void)lane; (void)gw; (void)nw; (void)gt; (void)nt; \
        typedef const __attribute__((address_space(4))) Args* kargp_t; kargp_t ap = (kargp_t)__builtin_amdgcn_kernarg_segment_ptr(); asm volatile("" : "+s"(ap)); \
        unsigned char* const ws = ap->ws; float* const outp = ap->out; (void)outp;
#define PH_END(phid) \
        if ((phid) + 1 < hi) { XcdBarrier b2; b2.bar = (unsigned*)(ap->ws + WS_CTL) + CW_BAR + ap->li * XCD_BAR_WORDS; b2.x = xb_xcc_id(); b2.st = MISC + 8; xcd_barrier(b2, tid); } }
#define W_(T, off) ((T*)(ws + (off)))
#define IN_(i) (ap->in[i])
    PH_BEGIN(0) if (MOE_F8) ph_convert_experts8(ap, lds + RING_OFF, bx, G, tid); ph_convert(ap, lds, gw, nw, wave, lane); ph_rope_table(W_(float, WS_ROPE), gt, nt); ph_router_table(IN_(14), IN_(13), W_(bf16_t, WS_WRH), W_(bf16_t, WS_WRL), gt, nt); if (PROJ_I8) { if (OUT_I8) ph_colmax(IN_(2), IN_(12), W_(unsigned, WS_CTL) + CW_CMAX_IN, W_(unsigned, WS_CTL) + CW_CMAX_OUT, gt, nt); else ph_quant_win_fused(IN_(2), ws + WS_WIN, W_(unsigned, WS_CTL) + CW_CMAX_IN, lds + RING_OFF, bx, G, tid); ph_rmsnorm_i8(IN_(0), IN_(1), ws + WS_HN, W_(float, WS_SA), gw, nw, lane); } PH_END(0)
#define P_RMS(l) \
    PH_BEGIN(1 + 12 * (l) + K_RMS) if ((l) == 0) { \
        if (PROJ_I8) { ph_quant_weights(IN_(2), IN_(12), ws + WS_WIN, ws + WS_WOUT, W_(unsigned, WS_CTL) + CW_CMAX_IN, W_(unsigned, WS_CTL) + CW_CMAX_OUT, lds, gw, nw, wave, lane); \
            } \
        else ph_rmsnorm(IN_(0), IN_(1) + (l) * D, W_(bf16_t, WS_HN), gw, nw, lane); } PH_END(1 + 12 * (l) + K_RMS)
#define P_INPROJ(l) \
    PH_BEGIN(1 + 12 * (l) + K_INPROJ) { if (PROJ_I8) { g8::DenseOrder S; S.init(M, NPROJ_PAD, G, bx, ws + WS_WIN + (size_t)(l) * NPROJ_PAD * D, 1); \
            g8::EpiProjI8 E{W_(bf16_t, WS_PROJ), NPROJ_PAD, W_(const float, WS_SA), W_(const unsigned, WS_CTL) + CW_CMAX_IN + (l) * NPROJ_PAD, (LAS float*)(lds + LBIAS_OFF)}; \
            g8::gemm_phase<g8::EpiProjI8, g8::DenseOrder, true, 2>(lds + RING_OFF, ws + WS_HN, S, E, tid); } \
        else { g8::DenseOrder S; S.init(M, NPROJ_PAD, G, bx, W_(const bf16_t, WS_WIN) + (size_t)(l) * NPROJ_PAD * D); g8::EpiProj E{W_(bf16_t, WS_PROJ), NPROJ_PAD}; \
            g8::gemm_phase<g8::EpiProj, g8::DenseOrder, true>(lds + RING_OFF, W_(const bf16_t, WS_HN), S, E, tid); } } PH_END(1 + 12 * (l) + K_INPROJ)
#define P_POST(l) \
    PH_BEGIN(1 + 12 * (l) + K_POST) { bf16_t* PROJ = W_(bf16_t, WS_PROJ); ph_qkrope(PROJ, IN_(3) + (l) * HD, IN_(4) + (l) * HD, W_(const float, WS_ROPE), W_(unsigned, WS_QKMAX) + 4096 * (l), gt, nt); ph_conv(PROJ, IN_(5) + (l) * 5 * 1024, IN_(6) + (l) * 1024, W_(bf16_t, WS_XBC), gt, nt); \
        ph_dt(PROJ, IN_(7) + (l) * 16, W_(float, WS_DT), gt, nt); } PH_END(1 + 12 * (l) + K_POST)
#define P_SSDA(l) \
    PH_BEGIN(1 + 12 * (l) + K_SSDA) { float* DECF = W_(float, WS_DEC); ssd::phase_a(lds + RING_OFF, W_(const bf16_t, WS_XBC), W_(const float, WS_DT), IN_(8) + (l) * 16, W_(bf16_t, WS_STF), W_(bf16_t, WS_STB), DECF, DECF + 1024, G, bx, tid); } PH_END(1 + 12 * (l) + K_SSDA)
#define P_SCAN(l) \
    PH_BEGIN(1 + 12 * (l) + K_SCAN) { float* DECF = W_(float, WS_DEC); ph_scan(W_(const bf16_t, WS_STF), W_(const bf16_t, WS_STB), W_(bf16_t, WS_PRVF), W_(bf16_t, WS_PRVB), DECF, DECF + 1024, gt, nt); } PH_END(1 + 12 * (l) + K_SCAN)
#define P_MIXER(l) \
    PH_BEGIN(1 + 12 * (l) + K_MIXER) { \
        ssd::phase_b(lds + RING_OFF, W_(const bf16_t, WS_XBC), W_(const bf16_t, WS_PROJ), W_(const float, WS_DT), IN_(8) + (l) * 16, IN_(9) + (l) * 8, IN_(10) + (l) * 512, W_(const bf16_t, WS_PRVF), W_(const bf16_t, WS_PRVB), W_(bf16_t, WS_MIX), G, bx, tid); \
        bf16_t* PROJ = W_(bf16_t, WS_PROJ); \
        const attn_body::AttnTensors AT{(const attn_body::bf16*)(PROJ + C_Q), (const attn_body::bf16*)(PROJ + C_K), (const attn_body::bf16*)(PROJ + C_V), (attn_body::bf16*)W_(bf16_t, WS_MIX), NORM_FOLD ? W_(float, WS_SSQ) : (float*)nullptr}; \
        attn_body::attn_phase<8>((char*)lds_raw + RING_OFF, AT, W_(const unsigned, WS_QKMAX) + 4096 * (l), G, bx, tid); } PH_END(1 + 12 * (l) + K_MIXER)
#if NORM_FOLD && !OUT_I8
#define P_NORMS(l)
#else
#define P_NORMS(l) \
    PH_BEGIN(1 + 12 * (l) + K_NORMS) if (OUT_I8) ph_attnnorm_i8(W_(const bf16_t, WS_MIX), IN_(11) + (l) * 512, ws + WS_MIXQ, W_(float, WS_SM), gw, nw, lane); \
        else if (!NORM_FOLD) ph_attnnorm(W_(bf16_t, WS_MIX), IN_(11) + (l) * 512, gw, nw, lane); PH_END(1 + 12 * (l) + K_NORMS)
#endif
#define P_OUTPROJ(l) \
    PH_BEGIN(1 + 12 * (l) + K_OUTPROJ) { if (OUT_I8) { g8::DenseOrder S; S.init(M, D, G, bx, ws + WS_WOUT + (size_t)(l) * D * D, 1); \
            g8::EpiResidI8 E{(l) == 0 ? IN_(0) : (const float*)outp, outp, W_(const float, WS_SM), W_(const unsigned, WS_CTL) + CW_CMAX_OUT + (l) * D, (LAS float*)(lds + LBIAS_OFF)}; \
            g8::gemm_phase<g8::EpiResidI8, g8::DenseOrder, false, 2>(lds + RING_OFF, ws + WS_MIXQ, S, E, tid); } \
        else { g8::DenseOrder S; S.init(M, D, G, bx, W_(const bf16_t, WS_WOUT) + (size_t)(l) * D * D); g8::EpiResidB<(l) == 0> E{NORM_FOLD ? W_(const float, WS_SSQ) : (const float*)nullptr, (LAS float*)(lds + LBIAS_OFF), (l) == 0 ? (const void*)IN_(0) : (const void*)(ws + WS_XR), W_(bf16_t, WS_XR)}; \
            g8::gemm_phase<g8::EpiResidB<(l) == 0>, g8::DenseOrder, false, 0, 0, NORM_FOLD != 0>(lds + RING_OFF, W_(const bf16_t, WS_MIX), S, E, tid); } } PH_END(1 + 12 * (l) + K_OUTPROJ)
#define P_ROUTER(l) \
    PH_BEGIN(1 + 12 * (l) + K_ROUTER) ph_router(W_(const bf16_t, WS_XR), IN_(13) + (l) * D, W_(const bf16_t, WS_WRH) + (size_t)(l) * NE * D, W_(const bf16_t, WS_WRL) + (size_t)(l) * NE * D, IN_(15) + (l) * NE, W_(bf16_t, WS_HN), W_(int, WS_CTL) + CW_CNT + (l) * NE, W_(int, WS_SEG), W_(int, WS_TKE), W_(float, WS_TKW), W_(int, WS_TKR), lds + RING_OFF, bx, G, tid); PH_END(1 + 12 * (l) + K_ROUTER)
#define P_GU(l) \
    PH_BEGIN(1 + 12 * (l) + K_GU) { LAS int* tab = (LAS int*)(lds + RING_BYTES + 1024); g8::expert_table(W_(int, WS_CTL) + CW_CNT + (l) * NE, tab, 8, tid); \
        g8::ExpertOrder S{tab, 8, 4, G, bx, ws + WS_WGU + (size_t)(l) * NE * 2048 * D * (MOE_F8 ? 1 : 2), (size_t)2048 * D, W_(int, WS_SEG), true, MOE_F8 ? 1 : 2, (LAS unsigned short*)(lds + GIDX_OFF)}; g8::EpiGU<MOE_F8 != 0> E{ws + WS_ACT, IN_(17) + (size_t)(l) * NE * DE, IN_(19) + (size_t)(l) * NE * DE, (LAS float*)(lds + LBIAS_OFF)}; \
        g8::gemm_phase<g8::EpiGU<MOE_F8 != 0>, g8::ExpertOrder, true, MOE_F8 != 0>(lds + RING_OFF, ws + WS_HN, S, E, tid); } PH_END(1 + 12 * (l) + K_GU)
#define P_DOWN(l) \
    PH_BEGIN(1 + 12 * (l) + K_DOWN) { LAS int* tab = (LAS int*)(lds + RING_BYTES + 1024); g8::expert_table(W_(int, WS_CTL) + CW_CNT + (l) * NE, tab, 4, tid); \
        g8::ExpertOrder S{tab, 4, 8, G, bx, ws + WS_WD + (size_t)(l) * NE * D * DE * (MOE_F8 ? 1 : 2), (size_t)D * DE, W_(int, WS_SEG), false, MOE_F8 ? 1 : 2, (LAS unsigned short*)(lds + GIDX_OFF)}; g8::EpiDown<MOE_F8 != 0> E{W_(bf16_t, WS_YS), IN_(21) + (size_t)(l) * NE * D, (LAS float*)(lds + LBIAS_OFF)}; \
        g8::gemm_phase<g8::EpiDown<MOE_F8 != 0>, g8::ExpertOrder, true, MOE_F8 != 0>(lds + RING_OFF, ws + WS_ACT, S, E, tid); } PH_END(1 + 12 * (l) + K_DOWN)
#define P_COMBINE(l) \
    PH_BEGIN(1 + 12 * (l) + K_COMBINE) ph_combine(W_(const bf16_t, WS_XR), (l) + 1 < DEPTH ? W_(bf16_t, WS_XR) : (bf16_t*)nullptr, outp, W_(bf16_t, WS_YS), W_(int, WS_CTL) + CW_CNT + (l) * NE, W_(int, WS_TKE), W_(float, WS_TKW), W_(int, WS_TKR), (LAS int*)(lds + RING_OFF), (l) + 1 < DEPTH ? IN_(1) + ((l) + 1) * D : (const float*)nullptr, W_(bf16_t, WS_HN), W_(float, WS_SA), gw, nw, lane, tid); PH_END(1 + 12 * (l) + K_COMBINE)
#ifndef RT_SKIP
#define RT_SKIP 0
#endif
#define PX_QKROPE(l) PH_BEGIN(1 + 12 * (l) + K_POST) ph_qkrope(W_(bf16_t, WS_ACT), IN_(3) + (l) * HD, IN_(4) + (l) * HD, W_(const float, WS_ROPE), W_(unsigned, WS_QKMAX) + 4096 * 2, gt, nt); PH_END(1 + 12 * (l) + K_POST)
#define PX_CONVDT(l) PH_BEGIN(1 + 12 * (l) + K_POST) { bf16_t* PROJ = W_(bf16_t, WS_PROJ); ph_conv(PROJ, IN_(5) + (l) * 5 * 1024, IN_(6) + (l) * 1024, W_(bf16_t, WS_XBC), gt, nt); ph_dt(PROJ, IN_(7) + (l) * 16, W_(float, WS_DT), gt, nt); } PH_END(1 + 12 * (l) + K_POST)
#define PX_NORMS(l) PH_BEGIN(1 + 12 * (l) + K_NORMS) ph_attnnorm(W_(bf16_t, WS_ACT), IN_(11) + (l) * 512, gw, nw, lane); PH_END(1 + 12 * (l) + K_NORMS)
#define PX_ROUTER(l) PH_BEGIN(1 + 12 * (l) + K_ROUTER) ph_router(W_(const bf16_t, WS_XR), IN_(13) + (l) * D, W_(const bf16_t, WS_WRH) + (size_t)(l) * NE * D, W_(const bf16_t, WS_WRL) + (size_t)(l) * NE * D, IN_(15) + (l) * NE, W_(bf16_t, WS_ACT), W_(int, WS_CTL) + CW_CNT + 128, (int*)(ws + WS_ACT + 40 * MiB), (int*)(ws + WS_ACT + 48 * MiB), (float*)(ws + WS_ACT + 50 * MiB), (int*)(ws + WS_ACT + 52 * MiB), lds + RING_OFF, bx, G, tid, RT_SKIP); PH_END(1 + 12 * (l) + K_ROUTER)
#define PX_COMBINE(l) PH_BEGIN(1 + 12 * (l) + K_COMBINE) ph_combine(W_(const bf16_t, WS_XR), (bf16_t*)nullptr, (float*)(ws + WS_ACT), W_(bf16_t, WS_YS), W_(int, WS_CTL) + CW_CNT + (l) * NE, W_(int, WS_TKE), W_(float, WS_TKW), W_(int, WS_TKR), (LAS int*)(lds + RING_OFF), (const float*)nullptr, W_(bf16_t, WS_HN), W_(float, WS_SA), gw, nw, lane, tid); PH_END(1 + 12 * (l) + K_COMBINE)
#define PX_GUP(l, PRB) PH_BEGIN(1 + 12 * (l) + K_GU) { LAS int* tab = (LAS int*)(lds + RING_BYTES + 1024); g8::expert_table(W_(int, WS_CTL) + CW_CNT + (l) * NE, tab, 8, tid); \
        g8::ExpertOrder S{tab, 8, 4, G, bx, ws + WS_WGU + (size_t)(l) * NE * 2048 * D * (MOE_F8 ? 1 : 2), (size_t)2048 * D, W_(int, WS_SEG), true, MOE_F8 ? 1 : 2, (LAS unsigned short*)(lds + GIDX_OFF)}; g8::EpiGU<MOE_F8 != 0> E{ws + WS_ACT, IN_(17) + (size_t)(l) * NE * DE, IN_(19) + (size_t)(l) * NE * DE, (LAS float*)(lds + LBIAS_OFF)}; \
        g8::gemm_phase<g8::EpiGU<MOE_F8 != 0>, g8::ExpertOrder, true, MOE_F8 != 0, PRB>(lds + RING_OFF, ws + WS_HN, S, E, tid); } PH_END(1 + 12 * (l) + K_GU)
#define PX_GU1(l) PX_GUP(l, 3)
#define PX_GU2(l) PX_GUP(l, 2)
#ifndef DUP_RMS
#define DUP_RMS(l)
#endif
#ifndef DUP_INPROJ
#define DUP_INPROJ(l)
#endif
#ifndef DUP_POST
#define DUP_POST(l)
#endif
#ifndef DUP_SSDA
#define DUP_SSDA(l)
#endif
#ifndef DUP_SCAN
#define DUP_SCAN(l)
#endif
#ifndef DUP_MIXER
#define DUP_MIXER(l)
#endif
#ifndef DUP_NORMS
#define DUP_NORMS(l)
#endif
#ifndef DUP_OUTPROJ
#define DUP_OUTPROJ(l)
#endif
#ifndef DUP_ROUTER
#define DUP_ROUTER(l)
#endif
#ifndef DUP_GU
#define DUP_GU(l)
#endif
#ifndef DUP_DOWN
#define DUP_DOWN(l)
#endif
#ifndef DUP_COMBINE
#define DUP_COMBINE(l)
#endif
#define DUP1_0(P) P(0)
#define DUP1_1(P)
#if PROJ_I8 && !OUT_I8
#define P_RMS0(l)
#else
#define P_RMS0(l) P_RMS(l)
#endif
#define P_RMS1(l)
#define LAYER(l) P_RMS##l(l) DUP_RMS(l) P_INPROJ(l) DUP_INPROJ(l) P_POST(l) DUP_POST(l) P_SSDA(l) DUP_SSDA(l) P_SCAN(l) DUP_SCAN(l) P_MIXER(l) DUP_MIXER(l) P_NORMS(l) DUP_NORMS(l) P_OUTPROJ(l) DUP_OUTPROJ(l) P_ROUTER(l) DUP_ROUTER(l) P_GU(l) DUP_GU(l) P_DOWN(l) DUP_DOWN(l) P_COMBINE(l) DUP_COMBINE(l)
    LAYER(0)
    LAYER(1)
}

extern "C" void kernel_launch(void* const* d_in, const int* in_sizes, int n_in, void* d_out, int out_size, void* d_ws, size_t ws_size, hipStream_t stream) {
    static int grid = 0;
    if (grid == 0) {
        if (n_in != 22 || out_size != M * D || ws_size < WS_END) { fprintf(stderr, "kernel_launch: unexpected shapes n_in %d out %d ws %zu (need %zu)\n", n_in, out_size, ws_size, (size_t)WS_END); grid = -1; return; }
        int dev = 0, cus = 0;
        if (hipGetDevice(&dev) != hipSuccess || hipDeviceGetAttribute(&cus, hipDeviceAttributeMultiprocessorCount, dev) != hipSuccess) { grid = -1; return; }
        if (hipFuncSetAttribute((const void*)mega, hipFuncAttributeMaxDynamicSharedMemorySize, LDS_BYTES) != hipSuccess) { fprintf(stderr, "kernel_launch: hipFuncSetAttribute failed\n"); grid = -1; return; }
        int per_cu = 0; (void)hipOccupancyMaxActiveBlocksPerMultiprocessor(&per_cu, (const void*)mega, WG, LDS_BYTES); (void)hipGetLastError();
        if (per_cu < 1) fprintf(stderr, "kernel_launch: occupancy query says %d blocks/CU\n", per_cu);
        grid = cus;
    }
    if (grid < 0) return;
    const float* in[22]; for (int i = 0; i < 22; ++i) in[i] = (const float*)d_in[i];
    unsigned char* ws = (unsigned char*)d_ws; float* out = (float*)d_out;
    bf16_t* Win_t = (bf16_t*)(ws + WS_WIN); bf16_t* Wout_t = (bf16_t*)(ws + WS_WOUT); bf16_t* Wgu_t = (bf16_t*)(ws + WS_WGU); bf16_t* Wd_t = (bf16_t*)(ws + WS_WD);
    bf16_t* HN = (bf16_t*)(ws + WS_HN); bf16_t* PROJ = (bf16_t*)(ws + WS_PROJ); bf16_t* XBC = (bf16_t*)(ws + WS_XBC); float* DT = (float*)(ws + WS_DT); bf16_t* MIX = (bf16_t*)(ws + WS_MIX);
    float* STF = (float*)(ws + WS_STF); float* STB = (float*)(ws + WS_STB); float* YTMP = (float*)(ws + WS_YTMP); bf16_t* ACT = (bf16_t*)(ws + WS_ACT); bf16_t* YS = (bf16_t*)(ws + WS_YS);
    int* SEG = (int*)(ws + WS_SEG); float* DECF = (float*)(ws + WS_DEC); float* DECB = DECF + 1024;
    int* CNT = (int*)(ws + WS_CTL) + CW_CNT;
    (void)hipMemsetAsync(ws + WS_CTL, 0, CTL_BYTES, stream);
    Args a{}; for (int i = 0; i < 22; ++i) a.in[i] = in[i]; a.out = out; a.ws = ws;
    int li = 0;
    auto launch = [&](int lo, int hi) { a.ph_lo = lo; a.ph_hi = hi; a.li = li++; hipLaunchKernelGGL(mega, dim3(grid), dim3(WG), LDS_BYTES, stream, a); };
    launch(0, NPHASES);
}
```

```cpp
#include <hip/hip_runtime.h>
#include <cstdint>
#include <cstdio>

typedef unsigned short bf16_t;
typedef short bf16x8 __attribute__((ext_vector_type(8)));
typedef float f32x4 __attribute__((ext_vector_type(4)));
typedef unsigned u32x4 __attribute__((ext_vector_type(4)));
typedef unsigned u32x2 __attribute__((ext_vector_type(2)));

constexpr int D = 1024, BATCH = 2, SEQ = 8192, M = BATCH * SEQ, DEPTH = 2;
constexpr int NPROJ = 2320, NPROJ_PAD = 2560;
constexpr int C_Q = 0, C_K = 512, C_V = 640, C_Z = 768, C_XBC = 1280, C_DT = 2304;
constexpr int NH = 8, NKV = 2, HD = 64;
constexpr int SH = 8, SP = 64, SN = 128, SG = 2, CHUNK = 128, NCHUNK = SEQ / CHUNK;
constexpr int NE = 32, TOPK = 4, DE = 1024;
constexpr int ACT_ROWS = M * TOPK + NE * 256;
constexpr float EPS = 1e-6f;
constexpr float C2 = 0.125f * 1.4426950408889634f;

constexpr size_t MiB = 1u << 20;
constexpr size_t WS_CTL = 0;
constexpr size_t CTL_BYTES = 1 * MiB;
constexpr size_t WS_WIN = 1 * MiB;
constexpr size_t WS_WOUT = WS_WIN + 10 * MiB;
constexpr size_t WS_WGU = WS_WOUT + 4 * MiB;
constexpr size_t WS_WD = WS_WGU + 256 * MiB;
constexpr size_t WS_HN = WS_WD + 128 * MiB;
constexpr size_t WS_PROJ = WS_HN + 32 * MiB;
constexpr size_t WS_XBC = WS_PROJ + 80 * MiB;
constexpr size_t WS_DT = WS_XBC + 32 * MiB;
constexpr size_t WS_MIX = WS_DT + 1 * MiB;
constexpr size_t WS_STF = WS_MIX + 32 * MiB;
constexpr size_t WS_STB = WS_STF + 32 * MiB;
constexpr size_t WS_YTMP = WS_STB + 32 * MiB;
constexpr size_t WS_ACT = WS_YTMP + 32 * MiB;
constexpr size_t WS_YS = WS_ACT + 144 * MiB;
constexpr size_t WS_TKE = WS_YS + 144 * MiB;
constexpr size_t WS_TKW = WS_TKE + 256 * 1024;
constexpr size_t WS_TKR = WS_TKW + 256 * 1024;
constexpr size_t WS_SEG = WS_TKR + 256 * 1024;
constexpr size_t WS_DEC = WS_SEG + 2 * MiB;
constexpr size_t WS_ROPE = WS_DEC + 64 * 1024;
constexpr size_t WS_WRH = WS_ROPE + 64 * 1024;
constexpr size_t WS_WRL = WS_WRH + 128 * 1024;
constexpr size_t WS_SA = WS_WRL + 128 * 1024;
constexpr size_t WS_SM = WS_SA + 64 * 1024;
constexpr size_t WS_SSQ = WS_SM + 64 * 1024;
constexpr size_t WS_END = WS_SSQ + 512 * 1024;
constexpr size_t WS_XR = WS_YS + 80 * MiB;
constexpr size_t WS_V8T = WS_YS + 112 * MiB;
constexpr size_t WS_K8 = WS_YS + 114 * MiB;
constexpr size_t WS_MIXQ = WS_XBC;
constexpr size_t WS_PRVF = WS_YTMP, WS_PRVB = WS_YTMP + 16 * MiB;
constexpr int CW_CNT = 1024;
constexpr size_t WS_QKMAX = WS_DEC + 16 * 1024;
constexpr int CW_CMAX_IN = 232000, CW_CMAX_OUT = CW_CMAX_IN + DEPTH * NPROJ_PAD;


typedef float hdr_f32x2 __attribute__((ext_vector_type(2))); typedef __bf16 hdr_bf16x2 __attribute__((ext_vector_type(2)));
__device__ __forceinline__ unsigned pk2(float lo, float hi) { const hdr_f32x2 v = {lo, hi}; return __builtin_bit_cast(unsigned, __builtin_convertvector(v, hdr_bf16x2)); }
__device__ __forceinline__ unsigned f2bf(float f) { return pk2(f, 0.f) & 0xffffu; }
__device__ __forceinline__ float bf2f(unsigned b) { return __uint_as_float(b << 16); }
__device__ __forceinline__ float wave_sum(float v) {
#pragma unroll
    for (int o = 1; o < 64; o <<= 1) v += __shfl_xor(v, o);
    return v;
}
__device__ __forceinline__ int undef32_() { int u; asm("" : "=v"(u)); return u; }
#define UNDEF32() undef32_()
__device__ __forceinline__ float silu_f(float v) { return v * __builtin_amdgcn_rcpf(1.f + __expf(-v)); }

#ifndef WT_STORES
#define WT_STORES 0
#endif
__device__ __forceinline__ void st16_wt(void* p, u32x4 v) {
#if WT_STORES
    asm volatile("global_store_dwordx4 %0, %1, off sc1\n\ts_nop 1" :: "v"(p), "v"(v) : "memory");
#else
    *(u32x4*)p = v;
#endif
}
#ifndef WEXP_TILED
#define WEXP_TILED 1
#endif
#ifndef ACT_TILED
#define ACT_TILED 0
#endif
#ifndef PROJ_I8
#define PROJ_I8 1
#endif
#ifndef OUT_I8
#define OUT_I8 0
#endif
#ifndef NORM_FOLD
#define NORM_FOLD 1
#endif
#ifndef YS_F8
#define YS_F8 1
#endif
#ifndef MOE_F8
#define MOE_F8 1
#endif
#define GAS __attribute__((address_space(1)))
#define LAS __attribute__((address_space(3)))
typedef GAS unsigned gu32;
#define RLX_AGENT __ATOMIC_RELAXED, __HIP_MEMORY_SCOPE_AGENT
constexpr int NWAVES = 8, WG = NWAVES * 64;
constexpr int RING_OFF = 0, RING_BYTES = 131072;
constexpr int LDSCTL_OFF = RING_BYTES, MISC_OFF = LDSCTL_OFF + 320;
constexpr int LDS_BYTES = 155648;
constexpr int GIDX_OFF = RING_BYTES + 4096, LBIAS_OFF = RING_BYTES + 10240, MAXORD = 12;
constexpr int CW_BAR = 4096;

#define XB_TMO      128
#define XB_XCNT(j)  (256  + 64 * (j))
#define XB_XSUB(j)  (1280 + 64 * (j))
#define XB_XGEN(j)  (2304 + 64 * (j))
#define XB_TOP      3328
#define XB_TOPGEN   3392
#define XCD_BAR_WORDS 3456
#define XB_SPIN_CAP (1u << 18)
__device__ __forceinline__ unsigned xb_ld(unsigned* p)              { return __hip_atomic_load(p, __ATOMIC_RELAXED, __HIP_MEMORY_SCOPE_AGENT); }
__device__ __forceinline__ unsigned xb_add(unsigned* p, unsigned v) { return __hip_atomic_fetch_add(p, v, __ATOMIC_RELAXED, __HIP_MEMORY_SCOPE_AGENT); }
__device__ __forceinline__ unsigned xb_xcc_id() { return (unsigned)__builtin_amdgcn_s_getreg((3 << 11) | 20) & 0xFu; }
#define XB_SPIN(cond, bar) do { unsigned _sp = 0; while (cond) { __builtin_amdgcn_s_sleep(1); \
    if ((++_sp & 255u) == 0u) { if (xb_ld(&(bar)[XB_TMO])) break; if (_sp > XB_SPIN_CAP) { atomicAdd(&(bar)[XB_TMO], 1u); break; } } } } while (0)
struct XcdBarrier { unsigned* bar; unsigned x; volatile LAS unsigned* st; };
__device__ __forceinline__ XcdBarrier xcd_barrier_post(unsigned* bar, volatile LAS unsigned* st) {
    XcdBarrier b; b.bar = bar; b.x = xb_xcc_id(); b.st = st;
    if (threadIdx.x == 0) (void)xb_add(&bar[XB_XCNT(b.x)], 1u);
    return b;
}
__device__ __forceinline__ void xcd_barrier_complete(unsigned* bar, unsigned x, unsigned& nloc, unsigned& nx) {
    const unsigned G = gridDim.x * gridDim.y * gridDim.z;
    unsigned sum, cnt, mine, sp = 0u;
    for (;;) {
        sum = 0u; cnt = 0u; mine = 0u;
#pragma unroll
        for (unsigned j = 0; j < 16; ++j) { const unsigned c = xb_ld(&bar[XB_XCNT(j)]); sum += c; cnt += (c > 0u) ? 1u : 0u; mine = (j == x) ? c : mine; }
        if (sum == G) break;
        __builtin_amdgcn_s_sleep(1);
        if ((++sp & 255u) == 0u) { if (xb_ld(&bar[XB_TMO])) break; if (sp > XB_SPIN_CAP) { atomicAdd(&bar[XB_TMO], 1u); break; } }
    }
    nloc = mine > 0u ? mine : 1u; nx = cnt > 0u ? cnt : 1u;
}
__device__ __forceinline__ void xcd_barrier(const XcdBarrier& b, const int tid) {
    asm volatile("s_waitcnt vmcnt(0)" ::: "memory");
    __syncthreads();
    if (tid == 0) {
        unsigned* bar = b.bar;
        __builtin_amdgcn_s_waitcnt(0);
        unsigned nloc = b.st[0], nx = b.st[1];
        if (nloc == 0u) { xcd_barrier_complete(bar, b.x, nloc, nx); b.st[0] = nloc; b.st[1] = nx; }
        const unsigned old = xb_add(&bar[XB_XSUB(b.x)], 1u);
        const unsigned gen = old / nloc;
        if (old + 1u == (gen + 1u) * nloc) {
            __builtin_amdgcn_fence(__ATOMIC_RELEASE, "agent");
            asm volatile("s_waitcnt vmcnt(0)" ::: "memory");
            const unsigned og = xb_add(&bar[XB_TOP], 1u);
            const unsigned tg = og / nx;
            if (og + 1u == (tg + 1u) * nx) xb_add(&bar[XB_TOPGEN], 1u);
            else XB_SPIN(xb_ld(&bar[XB_TOPGEN]) == tg, bar);
            __builtin_amdgcn_fence(__ATOMIC_ACQUIRE, "agent");
            xb_add(&bar[XB_XGEN(b.x)], 1u);
            asm volatile("s_waitcnt vmcnt(0)" ::: "memory");
        } else {
            XB_SPIN(xb_ld(&bar[XB_XGEN(b.x)]) == gen, bar);
            __builtin_amdgcn_fence(__ATOMIC_ACQUIRE, "agent");
            asm volatile("s_waitcnt vmcnt(0)" ::: "memory");
        }
    }
    __syncthreads();
}

struct Args { const float* in[22]; float* out; unsigned char* ws; int ph_lo, ph_hi, li, pad; };
struct LP {
    const float *xin, *norm_mix, *q_norm, *k_norm, *conv_w, *conv_b, *dt_bias, *a_log, *d_skip, *ssm_norm, *attn_norm, *norm_ffn, *w_router, *b_router, *b_gate, *b_up, *b_down;
    const bf16_t *Win_t, *Wout_t, *Wgu_t, *Wd_t;
    int* cnt;
};
struct WSP {
    bf16_t *HN, *PROJ, *XBC, *MIX, *ACT, *YS; float *DT, *STF, *STB, *YTMP, *DECF, *DECB, *TKW; int *TKE, *TKR, *SEG;
};
__device__ __forceinline__ LP make_lp(const Args& a, int l) {
    LP p; const float* const* in = a.in; unsigned char* ws = a.ws;
    p.xin = l == 0 ? in[0] : a.out; p.norm_mix = in[1] + l * D; p.q_norm = in[3] + l * HD; p.k_norm = in[4] + l * HD; p.conv_w = in[5] + l * 5 * 1024; p.conv_b = in[6] + l * 1024;
    p.dt_bias = in[7] + l * 16; p.a_log = in[8] + l * 16; p.d_skip = in[9] + l * 8; p.ssm_norm = in[10] + l * 512; p.attn_norm = in[11] + l * 512; p.norm_ffn = in[13] + l * D;
    p.w_router = in[14] + (size_t)l * D * NE; p.b_router = in[15] + l * NE; p.b_gate = in[17] + (size_t)l * NE * DE; p.b_up = in[19] + (size_t)l * NE * DE; p.b_down = in[21] + (size_t)l * NE * D;
    p.Win_t = (const bf16_t*)(ws + WS_WIN) + (size_t)l * NPROJ_PAD * D; p.Wout_t = (const bf16_t*)(ws + WS_WOUT) + (size_t)l * D * D;
    p.Wgu_t = (const bf16_t*)(ws + WS_WGU) + (size_t)l * NE * 2048 * D; p.Wd_t = (const bf16_t*)(ws + WS_WD) + (size_t)l * NE * D * DE;
    p.cnt = (int*)(ws + WS_CTL) + CW_CNT + l * NE;
    return p;
}
__device__ __forceinline__ WSP make_wsp(unsigned char* ws) {
    WSP w; w.HN = (bf16_t*)(ws + WS_HN); w.PROJ = (bf16_t*)(ws + WS_PROJ); w.XBC = (bf16_t*)(ws + WS_XBC); w.MIX = (bf16_t*)(ws + WS_MIX); w.ACT = (bf16_t*)(ws + WS_ACT); w.YS = (bf16_t*)(ws + WS_YS);
    w.DT = (float*)(ws + WS_DT); w.STF = (float*)(ws + WS_STF); w.STB = (float*)(ws + WS_STB); w.YTMP = (float*)(ws + WS_YTMP); w.DECF = (float*)(ws + WS_DEC); w.DECB = w.DECF + 1024;
    w.TKE = (int*)(ws + WS_TKE); w.TKW = (float*)(ws + WS_TKW); w.TKR = (int*)(ws + WS_TKR); w.SEG = (int*)(ws + WS_SEG);
    return w;
}

__device__ __forceinline__ void convT_item(const float* __restrict__ W, int K, int N, bf16_t* __restrict__ WT, int mode, LAS float* scr, int item, int lane, const float* rowgain = nullptr, int ngain = 0) {
    const int nblk = (N + 31) / 32, kb = item / nblk, nb = item % nblk, k0 = 64 * kb, n0 = 32 * nb;
#pragma unroll 8
    for (int i = 0; i < 32; ++i) { const int kk = 2 * i + (lane >> 5); const int n = n0 + (lane & 31); const float gk = (rowgain && k0 + kk < ngain) ? rowgain[k0 + kk] : 1.f; scr[kk * 33 + (lane & 31)] = (n < N) ? W[(size_t)(k0 + kk) * N + n] * gk : 0.f; }
    asm volatile("s_waitcnt lgkmcnt(0)" ::: "memory");
    const int c = lane & 7;
#pragma unroll
    for (int j = 0; j < 4; ++j) { const int nl = (lane >> 3) + 8 * j; const int n = n0 + nl; const LAS float* s = scr + (8 * c) * 33 + nl;
        u32x4 o; o.x = pk2(s[0 * 33], s[1 * 33]); o.y = pk2(s[2 * 33], s[3 * 33]); o.z = pk2(s[4 * 33], s[5 * 33]); o.w = pk2(s[6 * 33], s[7 * 33]);
        int drow = n; if (mode == 1) drow = 256 * (n >> 7) + (n & 127); else if (mode == 2) drow = 256 * (n >> 7) + 128 + (n & 127);
        if (n < N) *(u32x4*)(WT + (size_t)drow * K + k0 + 8 * c) = o; }
    asm volatile("s_waitcnt lgkmcnt(0)" ::: "memory");
}
__device__ __forceinline__ void convT_item8(const float* __restrict__ W, int K, int N, unsigned char* __restrict__ WT, int mode, LAS float* scr, int item, int lane) {
    const int nblk = (N + 31) / 32, kb = item / nblk, nb = item % nblk, k0 = 64 * kb, n0 = 32 * nb;
#pragma unroll 8
    for (int i = 0; i < 32; ++i) { const int kk = 2 * i + (lane >> 5); scr[kk * 33 + (lane & 31)] = __builtin_nontemporal_load(&W[(size_t)(k0 + kk) * N + n0 + (lane & 31)]); }
    asm volatile("s_waitcnt lgkmcnt(0)" ::: "memory");
    const int c = lane & 7;
#pragma unroll
    for (int j = 0; j < 4; ++j) { const int nl = (lane >> 3) + 8 * j; const int n = n0 + nl; const LAS float* s = scr + (8 * c) * 33 + nl;
        u32x2 o; { int v = __builtin_amdgcn_cvt_pk_fp8_f32(256.f * s[0 * 33], 256.f * s[1 * 33], UNDEF32(), false); v = __builtin_amdgcn_cvt_pk_fp8_f32(256.f * s[2 * 33], 256.f * s[3 * 33], v, true); o.x = (unsigned)v; }
        { int v = __builtin_amdgcn_cvt_pk_fp8_f32(256.f * s[4 * 33], 256.f * s[5 * 33], UNDEF32(), false); v = __builtin_amdgcn_cvt_pk_fp8_f32(256.f * s[6 * 33], 256.f * s[7 * 33], v, true); o.y = (unsigned)v; }
        int drow = n; if (mode == 1) drow = 256 * (n >> 7) + (n & 127); else if (mode == 2) drow = 256 * (n >> 7) + 128 + (n & 127);
        *(u32x2*)(WT + (size_t)drow * K + k0 + 8 * c) = o; }
    asm volatile("s_waitcnt lgkmcnt(0)" ::: "memory");
}
__device__ __forceinline__ void ph_convert_experts8(const __attribute__((address_space(4))) Args* a, LAS unsigned char* lds, int bx, int G, const int tid, const int probe = 0) {
    LAS float* scr = (LAS float*)lds;
    unsigned char* ws = a->ws;
    constexpr int NT = 3 * DEPTH * NE * 64;
    f32x4 rgA[8], rgB[8];
#define CV_SRC(T) ((((T) >> 12) == 0 ? a->in[16] : ((T) >> 12) == 1 ? a->in[18] : a->in[20]) + (size_t)(((T) & 4095) >> 6) * D * DE + (size_t)(((((T) & 4095) >> 3) & 7) * 128) * 1024 + ((T) & 7) * 128)
#define CV_LOAD(rg, T) do { if ((T) < NT) { const float* sp_ = CV_SRC(T); _Pragma("unroll") for (int i = 0; i < 8; ++i) { const int id = tid + i * 512; rg[i] = __builtin_nontemporal_load((const f32x4*)(sp_ + (size_t)(id >> 5) * 1024 + (id & 31) * 4)); } } } while (0)
#define CV_TILE(rg, T) do { \
        _Pragma("unroll") for (int i = 0; i < 8; ++i) { const int id = tid + i * 512, k_ = id >> 5; *(LAS f32x4*)(scr + k_ * 132 + (((id & 31) * 4) ^ ((k_ >> 4) << 3))) = rg[i]; } \
        __syncthreads(); \
        CV_LOAD(rg, (T) + 2 * G); \
        { const int kind = (T) >> 12, rem = (T) & 4095, le = rem >> 6, kt = (rem >> 3) & 7, nt_ = rem & 7; const int kc = tid & 7; \
          _Pragma("unroll") for (int ps = 0; ps < 2; ++ps) { const int n = (tid >> 3) + 64 * ps; \
            unsigned char* dst = kind == 2 ? ws + WS_WD + (size_t)le * D * DE + (size_t)(nt_ * 128 + n) * 1024 : ws + WS_WGU + (size_t)le * 2048 * D + (size_t)(256 * nt_ + (kind == 1 ? 128 : 0) + n) * 1024; \
            dst += kt * 128 + kc * 16; \
            if (WEXP_TILED) dst = (kind == 2 ? ws + WS_WD + ((size_t)le * 8 + nt_) * 131072 : ws + WS_WGU + ((size_t)le * 16 + 2 * nt_ + (kind == 1 ? 1 : 0)) * 131072) + (size_t)kt * 16384 + (size_t)n * 128 + kc * 16;        \
            unsigned w[4]; const LAS float* sp = scr + (16 * kc) * 132 + (n ^ (kc << 3)); \
            _Pragma("unroll") for (int j = 0; j < 4; ++j) { \
                int v = __builtin_amdgcn_cvt_pk_fp8_f32(256.f * sp[(4 * j) * 132], 256.f * sp[(4 * j + 1) * 132], UNDEF32(), false); v = __builtin_amdgcn_cvt_pk_fp8_f32(256.f * sp[(4 * j + 2) * 132], 256.f * sp[(4 * j + 3) * 132], v, true); w[j] = (unsigned)v; } \
            if (!(probe & 1)) { __builtin_nontemporal_store((u32x4){w[0], w[1], w[2], w[3]}, (u32x4*)dst); } else { asm volatile("" :: "v"(w[0]), "v"(w[1]), "v"(w[2]), "v"(w[3])); } } } \
        __syncthreads(); } while (0)
    int T = bx;
    CV_LOAD(rgA, T); CV_LOAD(rgB, T + G);
    for (; T < NT; T += 2 * G) {
        CV_TILE(rgA, T);
        if (T + G < NT) CV_TILE(rgB, T + G);
    }
#undef CV_SRC
#undef CV_LOAD
#undef CV_TILE
}
__device__ __forceinline__ void ph_convert(const __attribute__((address_space(4))) Args* a, LAS unsigned char* lds, int gw, int nw, int wave, int lane) {
    LAS float* scr = (LAS float*)(lds + wave * 16384);
    unsigned char* ws = a->ws;
    bf16_t* Win_t = (bf16_t*)(ws + WS_WIN); bf16_t* Wout_t = (bf16_t*)(ws + WS_WOUT); bf16_t* Wgu_t = (bf16_t*)(ws + WS_WGU); bf16_t* Wd_t = (bf16_t*)(ws + WS_WD);
    constexpr int I_IN = (D / 64) * ((NPROJ + 31) / 32), I_SQ = (D / 64) * (D / 32);
    constexpr int N_IN = DEPTH * I_IN, N_OUT = DEPTH * I_SQ, N_EXP = DEPTH * NE * I_SQ;
    constexpr int NITEMS = N_IN + N_OUT + (MOE_F8 ? 0 : 3 * N_EXP);
    for (int it = (PROJ_I8 ? gw + N_IN : gw); it < NITEMS; it += nw) {
        int r = it;
        if (r < N_IN) { const int l = r / I_IN; convT_item(a->in[2] + (size_t)l * D * NPROJ, D, NPROJ, Win_t + (size_t)l * NPROJ_PAD * D, 0, scr, r % I_IN, lane); continue; } r -= N_IN;
        if (r < N_OUT) { const int l = r / I_SQ; convT_item(a->in[12] + (size_t)l * D * D, D, D, Wout_t + (size_t)l * D * D, 0, scr, r % I_SQ, lane, NORM_FOLD ? a->in[11] + l * 512 : (const float*)nullptr, 512); continue; } r -= N_OUT;
#if MOE_F8
#else
        if (r < N_EXP) { const int le = r / I_SQ; convT_item(a->in[16] + (size_t)le * D * DE, D, DE, Wgu_t + (size_t)le * 2048 * D, 1, scr, r % I_SQ, lane); continue; } r -= N_EXP;
        if (r < N_EXP) { const int le = r / I_SQ; convT_item(a->in[18] + (size_t)le * D * DE, D, DE, Wgu_t + (size_t)le * 2048 * D, 2, scr, r % I_SQ, lane); continue; } r -= N_EXP;
        { const int le = r / I_SQ; convT_item(a->in[20] + (size_t)le * DE * D, DE, D, Wd_t + (size_t)le * D * DE, 0, scr, r % I_SQ, lane); }
#endif
    }
    const int gt = gw * 64 + lane, nt = nw * 64;
    for (int i = (PROJ_I8 ? 1 << 30 : gt); i < DEPTH * (NPROJ_PAD - NPROJ) * D / 8; i += nt) { const int l = i / ((NPROJ_PAD - NPROJ) * D / 8), o = i % ((NPROJ_PAD - NPROJ) * D / 8);
        *(u32x4*)(Win_t + (size_t)l * NPROJ_PAD * D + (size_t)NPROJ * D + (size_t)o * 8) = (u32x4){0u, 0u, 0u, 0u}; }
}
__device__ __forceinline__ float wave_max(float v) {
#pragma unroll
    for (int o = 1; o < 64; o <<= 1) v = fmaxf(v, __shfl_xor(v, o));
    return v;
}
__device__ __forceinline__ unsigned q4_i8(float a, float b, float c, float d, float inv) {
    const int q0 = (int)rintf(a * inv), q1 = (int)rintf(b * inv), q2 = (int)rintf(c * inv), q3 = (int)rintf(d * inv);
    return (unsigned)(q0 & 255) | ((unsigned)(q1 & 255) << 8) | ((unsigned)(q2 & 255) << 16) | ((unsigned)(q3 & 255) << 24);
}
__device__ __forceinline__ void ph_colmax(const float* w_in, const float* w_out, unsigned* cmax_in, unsigned* cmax_out, int gt, int nt) {
    constexpr int I_IN = DEPTH * 16 * NPROJ, I_OUT = DEPTH * 16 * D;
    for (int i = gt; i < I_IN + I_OUT; i += nt) {
        const bool isin = i < I_IN; const int r = isin ? i : i - I_IN, N = isin ? NPROJ : D; const int l = r / (16 * N), r2 = r % (16 * N), kb = r2 / N, n = r2 % N;
        const float* p = (isin ? w_in : w_out) + ((size_t)l * D + kb * 64) * N + n; float m = 0.f;
#pragma unroll 8
        for (int k = 0; k < 64; ++k) m = fmaxf(m, fabsf(p[(size_t)k * N]));
        atomicMax((isin ? cmax_in + l * NPROJ_PAD : cmax_out + l * D) + n, __float_as_uint(m));
    }
}
__device__ __forceinline__ void ph_quant_win_fused(const float* w_in, unsigned char* win8, unsigned* cmax_in, LAS unsigned char* lds, int bx, int G, const int tid) {
    constexpr int NB = (NPROJ + 31) / 32, TP = 1040;
    LAS float* red = (LAS float*)lds; LAS float* cm = (LAS float*)(lds + 8192); LAS unsigned char* T = lds + 8448;
    const int c4 = tid & 7, rg = tid >> 3, lane = tid & 63, wave = tid >> 6;
    __syncthreads();
    for (int it = bx; it < DEPTH * NB; it += G) { const int l = it / NB, n0 = 32 * (it % NB);
        const float* W = w_in + (size_t)l * D * NPROJ; const bool ok = n0 + 4 * c4 < NPROJ;
        f32x4 v[16]; float mx[4] = {0.f, 0.f, 0.f, 0.f};
#pragma unroll
        for (int i = 0; i < 16; ++i) { v[i] = ok ? *(const f32x4*)(W + (size_t)(rg + 64 * i) * NPROJ + n0 + 4 * c4) : (f32x4){0.f, 0.f, 0.f, 0.f};
#pragma unroll
            for (int j = 0; j < 4; ++j) mx[j] = fmaxf(mx[j], fabsf(v[i][j])); }
        *(LAS f32x4*)(red + rg * 32 + 4 * c4) = (f32x4){mx[0], mx[1], mx[2], mx[3]};
        __syncthreads();
        if (tid < 32) { float m = 0.f;
#pragma unroll 8
            for (int r = 0; r < 64; ++r) m = fmaxf(m, red[r * 32 + tid]);
            cm[tid] = m; if (n0 + tid < NPROJ) cmax_in[l * NPROJ_PAD + n0 + tid] = __float_as_uint(m); }
        __syncthreads();
        float inv[4];
#pragma unroll
        for (int j = 0; j < 4; ++j) { const float m = cm[4 * c4 + j]; inv[j] = m > 0.f ? 127.f / m : 0.f; }
#pragma unroll
        for (int i = 0; i < 16; ++i)
#pragma unroll
            for (int j = 0; j < 4; ++j) T[(4 * c4 + j) * TP + rg + 64 * i] = (unsigned char)((int)rintf(v[i][j] * inv[j]) & 255);
        __syncthreads();
#pragma unroll
        for (int r = 0; r < 4; ++r) { const int n = wave + 8 * r; if (n0 + n < NPROJ) *(u32x4*)(win8 + ((size_t)l * NPROJ_PAD + n0 + n) * D + lane * 16) = *(const LAS u32x4*)(T + n * TP + lane * 16); }
        __syncthreads();
    }
    const int gt = bx * 512 + tid, nt = G * 512;
    for (int i = gt; i < DEPTH * (NPROJ_PAD - NPROJ) * D / 16; i += nt) { const int l = i / ((NPROJ_PAD - NPROJ) * D / 16), o = i % ((NPROJ_PAD - NPROJ) * D / 16);
        *(u32x4*)(win8 + (size_t)l * NPROJ_PAD * D + (size_t)NPROJ * D + (size_t)o * 16) = (u32x4){0u, 0u, 0u, 0u}; }
}
__device__ __forceinline__ void convT_item_i8(const float* __restrict__ W, int K, int N, unsigned char* __restrict__ WT, const unsigned* cmax, LAS float* scr, int item, int lane) {
    const int nblk = (N + 31) / 32, kb = item / nblk, nb = item % nblk, k0 = 64 * kb, n0 = 32 * nb;
#pragma unroll 8
    for (int i = 0; i < 32; ++i) { const int kk = 2 * i + (lane >> 5); const int n = n0 + (lane & 31); scr[kk * 33 + (lane & 31)] = (n < N) ? W[(size_t)(k0 + kk) * N + n] : 0.f; }
    asm volatile("s_waitcnt lgkmcnt(0)" ::: "memory");
    const int c = lane & 7;
#pragma unroll
    for (int j = 0; j < 4; ++j) { const int nl = (lane >> 3) + 8 * j; const int n = n0 + nl; const LAS float* s = scr + (8 * c) * 33 + nl;
        if (n < N) { const float mx = __uint_as_float(cmax[n]); const float inv = mx > 0.f ? 127.f / mx : 0.f;
            u32x2 o; o.x = q4_i8(s[0 * 33], s[1 * 33], s[2 * 33], s[3 * 33], inv); o.y = q4_i8(s[4 * 33], s[5 * 33], s[6 * 33], s[7 * 33], inv);
            *(u32x2*)(WT + (size_t)n * K + k0 + 8 * c) = o; } }
    asm volatile("s_waitcnt lgkmcnt(0)" ::: "memory");
}
__device__ __forceinline__ void ph_quant_weights(const float* w_in, const float* w_out, unsigned char* win8, unsigned char* wout8, const unsigned* cmax_in, const unsigned* cmax_out, LAS unsigned char* lds,
                                                 int gw, int nw, int wave, int lane) {
    LAS float* scr = (LAS float*)(lds + wave * 16384);
    constexpr int I_IN = (D / 64) * ((NPROJ + 31) / 32), I_SQ = (D / 64) * (D / 32);
    for (int it = gw; it < DEPTH * (I_IN + (OUT_I8 ? I_SQ : 0)); it += nw) {
        if (it < DEPTH * I_IN) { const int l = it / I_IN; convT_item_i8(w_in + (size_t)l * D * NPROJ, D, NPROJ, win8 + (size_t)l * NPROJ_PAD * D, cmax_in + l * NPROJ_PAD, scr, it % I_IN, lane); }
        else { const int r = it - DEPTH * I_IN, l = r / I_SQ; convT_item_i8(w_out + (size_t)l * D * D, D, D, wout8 + (size_t)l * D * D, cmax_out + l * D, scr, r % I_SQ, lane); }
    }
    const int gt = gw * 64 + lane, nt = nw * 64;
    for (int i = gt; i < DEPTH * (NPROJ_PAD - NPROJ) * D / 16; i += nt) { const int l = i / ((NPROJ_PAD - NPROJ) * D / 16), o = i % ((NPROJ_PAD - NPROJ) * D / 16);
        *(u32x4*)(win8 + (size_t)l * NPROJ_PAD * D + (size_t)NPROJ * D + (size_t)o * 16) = (u32x4){0u, 0u, 0u, 0u}; }
}
__device__ __forceinline__ void ph_rmsnorm_i8(const float* __restrict__ x, const float* __restrict__ gain, unsigned char* __restrict__ outq, float* __restrict__ sA, int gw, int nw, int lane) {
    for (int m = gw; m < M; m += nw) {
        const f32x4* xr = (const f32x4*)(x + (size_t)m * D) + lane; f32x4 v[4]; float s = 0.f;
#pragma unroll
        for (int j = 0; j < 4; ++j) { v[j] = __builtin_nontemporal_load(xr + 64 * j); s += v[j].x * v[j].x + v[j].y * v[j].y + v[j].z * v[j].z + v[j].w * v[j].w; }
        const float rstd = 1.0f / sqrtf(wave_sum(s) * (1.f / D) + EPS); float mx = 0.f;
#pragma unroll
        for (int j = 0; j < 4; ++j) { const f32x4 g = ((const f32x4*)gain)[64 * j + lane]; v[j].x *= rstd * g.x; v[j].y *= rstd * g.y; v[j].z *= rstd * g.z; v[j].w *= rstd * g.w;
            mx = fmaxf(fmaxf(mx, fmaxf(fabsf(v[j].x), fabsf(v[j].y))), fmaxf(fabsf(v[j].z), fabsf(v[j].w))); }
        mx = wave_max(mx); const float inv = mx > 0.f ? 127.f / mx : 0.f;
        unsigned* o = (unsigned*)(outq + (size_t)m * D) + lane;
#pragma unroll
        for (int j = 0; j < 4; ++j) o[64 * j] = q4_i8(v[j].x, v[j].y, v[j].z, v[j].w, inv);
        if (lane == 0) sA[m] = mx * (1.f / 127.f);
    }
}
__device__ __forceinline__ void ph_rmsnorm(const float* __restrict__ x, const float* __restrict__ gain, bf16_t* __restrict__ out, int gw, int nw, int lane) {
    for (int m = gw; m < M; m += nw) {
        const f32x4* xr = (const f32x4*)(x + (size_t)m * D) + lane; f32x4 v[4]; float s = 0.f;
#pragma unroll
        for (int j = 0; j < 4; ++j) { v[j] = __builtin_nontemporal_load(xr + 64 * j); s += v[j].x * v[j].x + v[j].y * v[j].y + v[j].z * v[j].z + v[j].w * v[j].w; }
        const float rstd = 1.0f / sqrtf(wave_sum(s) * (1.f / D) + EPS);
        u32x2* o = (u32x2*)(out + (size_t)m * D) + lane;
#pragma unroll
        for (int j = 0; j < 4; ++j) { const f32x4 g = ((const f32x4*)gain)[64 * j + lane]; u32x2 w; w.x = pk2(v[j].x * rstd * g.x, v[j].y * rstd * g.y); w.y = pk2(v[j].z * rstd * g.z, v[j].w * rstd * g.w); o[64 * j] = w; }
    }
}
__device__ __forceinline__ void ph_qkrope(bf16_t* proj, const float* __restrict__ qn, const float* __restrict__ kn, const float* rope, unsigned* qkmax, unsigned char* k8, int gt, int nt) {
    const int gid = gt >> 2, part = gt & 3, half = part >> 1, c = part & 1, ng = nt >> 2;
    constexpr int TR = 5;
    u32x4 ra[TR], rb[TR]; float q2m = 0.f, k2m = 0.f;
#pragma unroll
    for (int it = 0; it < TR; ++it) { const int gh = gid + it * ng; if (gh < M * 10) { const int m = gh / 10, hs = gh % 10;
        const bf16_t* p = proj + (size_t)m * NPROJ_PAD + (hs < 8 ? C_Q + hs * 64 : C_K + (hs - 8) * 64) + half * 32 + c * 8; ra[it] = *(const u32x4*)p; rb[it] = *(const u32x4*)(p + 16); } }
#pragma unroll
    for (int it = 0; it < TR; ++it) { const int gh = gid + it * ng; if (gh >= M * 10) break;
        const int m = gh / 10, hs = gh % 10, t = m & (SEQ - 1);
        bf16_t* p = proj + (size_t)m * NPROJ_PAD + (hs < 8 ? C_Q + hs * 64 : C_K + (hs - 8) * 64) + half * 32 + c * 8;
        const float* gn = (hs < 8 ? qn : kn) + half * 32 + c * 8;
        const unsigned wa[4] = {ra[it].x, ra[it].y, ra[it].z, ra[it].w}, wb[4] = {rb[it].x, rb[it].y, rb[it].z, rb[it].w};
        float a[8], b[8]; float ss = 0.f;
#pragma unroll
        for (int k = 0; k < 4; ++k) { a[2 * k] = bf2f(wa[k] & 0xffffu); a[2 * k + 1] = bf2f(wa[k] >> 16); b[2 * k] = bf2f(wb[k] & 0xffffu); b[2 * k + 1] = bf2f(wb[k] >> 16); }
#pragma unroll
        for (int k = 0; k < 8; ++k) ss += a[k] * a[k] + b[k] * b[k];
        ss += __shfl_xor(ss, 1); ss += __shfl_xor(ss, 2);
        const float rstd = (1.0f / sqrtf(ss * (1.f / 64.f) + EPS)) * (hs < 8 ? C2 : 1.f);
        const float* tb = rope + (half ? (128 + (t & 63)) : (t >> 6)) * 32 + c * 8;
        const f32x4 c0v = *(const f32x4*)tb, c1v = *(const f32x4*)(tb + 4), s0v = *(const f32x4*)(tb + 16), s1v = *(const f32x4*)(tb + 20);
        const f32x4 ga = *(const f32x4*)gn, gb = *(const f32x4*)(gn + 4), gc = *(const f32x4*)(gn + 16), gd = *(const f32x4*)(gn + 20);
        const float csv[8] = {c0v.x, c0v.y, c0v.z, c0v.w, c1v.x, c1v.y, c1v.z, c1v.w}, snv[8] = {s0v.x, s0v.y, s0v.z, s0v.w, s1v.x, s1v.y, s1v.z, s1v.w};
        const float g1[8] = {ga.x, ga.y, ga.z, ga.w, gb.x, gb.y, gb.z, gb.w}, g2[8] = {gc.x, gc.y, gc.z, gc.w, gd.x, gd.y, gd.z, gd.w};
        unsigned oa[4], ob[4];
#pragma unroll
        for (int k = 0; k < 4; ++k) { float r0[2], r1[2];
#pragma unroll
            for (int e = 0; e < 2; ++e) { const int d = 2 * k + e; const float x1 = a[d] * rstd * g1[d], x2 = b[d] * rstd * g2[d], cs = csv[d], sn = snv[d]; r0[e] = x1 * cs - x2 * sn; r1[e] = x2 * cs + x1 * sn; }
            oa[k] = pk2(r0[0], r0[1]); ob[k] = pk2(r1[0], r1[1]); }
        *(u32x4*)p = (u32x4){oa[0], oa[1], oa[2], oa[3]}; *(u32x4*)(p + 16) = (u32x4){ob[0], ob[1], ob[2], ob[3]};
        float s2 = 0.f;
#pragma unroll
        for (int k = 0; k < 4; ++k) { const float x0 = __uint_as_float(oa[k] << 16), x1 = __uint_as_float(oa[k] & 0xffff0000u), y0 = __uint_as_float(ob[k] << 16), y1 = __uint_as_float(ob[k] & 0xffff0000u); s2 += x0 * x0 + x1 * x1 + y0 * y0 + y1 * y1; }
        s2 += __shfl_xor(s2, 1); s2 += __shfl_xor(s2, 2);
        if (hs < 8) q2m = fmaxf(q2m, s2); else { k2m = fmaxf(k2m, s2);
            float kv[16];
#pragma unroll
            for (int k = 0; k < 4; ++k) { kv[2 * k] = 0.25f * __uint_as_float(oa[k] << 16); kv[2 * k + 1] = 0.25f * __uint_as_float(oa[k] & 0xffff0000u); kv[8 + 2 * k] = 0.25f * __uint_as_float(ob[k] << 16); kv[8 + 2 * k + 1] = 0.25f * __uint_as_float(ob[k] & 0xffff0000u); }
            u32x4 w8;
            { int q = __builtin_amdgcn_cvt_pk_fp8_f32(kv[0], kv[1], UNDEF32(), false); q = __builtin_amdgcn_cvt_pk_fp8_f32(kv[2], kv[3], q, true); w8.x = (unsigned)q; }
            { int q = __builtin_amdgcn_cvt_pk_fp8_f32(kv[4], kv[5], UNDEF32(), false); q = __builtin_amdgcn_cvt_pk_fp8_f32(kv[6], kv[7], q, true); w8.y = (unsigned)q; }
            { int q = __builtin_amdgcn_cvt_pk_fp8_f32(kv[8], kv[9], UNDEF32(), false); q = __builtin_amdgcn_cvt_pk_fp8_f32(kv[10], kv[11], q, true); w8.z = (unsigned)q; }
            { int q = __builtin_amdgcn_cvt_pk_fp8_f32(kv[12], kv[13], UNDEF32(), false); q = __builtin_amdgcn_cvt_pk_fp8_f32(kv[14], kv[15], q, true); w8.w = (unsigned)q; }
            *(u32x4*)(k8 + (((size_t)(m >> 13) * NKV + (hs - 8)) * SEQ + t) * 64 + 32 * c + 16 * half) = w8; }
    }
#pragma unroll
    for (int o = 4; o < 64; o <<= 1) { q2m = fmaxf(q2m, __shfl_xor(q2m, o)); k2m = fmaxf(k2m, __shfl_xor(k2m, o)); }
    if ((gt & 63) == 0) { qkmax[(gt >> 6) * 2] = __float_as_uint(q2m); qkmax[(gt >> 6) * 2 + 1] = __float_as_uint(k2m); }
}
__device__ __forceinline__ void ph_v8t(const bf16_t* proj, unsigned char* v8t, int gw, int nw, int lane) {
    for (int it = gw; it < BATCH * NKV * (SEQ / 64) * 4; it += nw) { const int c = it & 3, tile = (it >> 2) % (SEQ / 64), bk = (it >> 2) / (SEQ / 64), kvh = bk % NKV, b = bk / NKV;
        const bf16_t* src = proj + ((size_t)b * SEQ + tile * 64) * NPROJ_PAD + C_V + kvh * 64 + lane;
        unsigned w[4];
#pragma unroll
        for (int p4 = 0; p4 < 4; ++p4) { float v[4];
#pragma unroll
            for (int e = 0; e < 4; ++e) { const int p = 16 * c + 4 * p4 + e, g = p >> 5, i = p & 31, key = (i & 3) + 8 * ((i & 15) >> 2) + 4 * g + 32 * (i >> 4); v[e] = 8.f * bf2f(src[(size_t)key * NPROJ_PAD]); }
            int q = __builtin_amdgcn_cvt_pk_fp8_f32(v[0], v[1], UNDEF32(), false); q = __builtin_amdgcn_cvt_pk_fp8_f32(v[2], v[3], q, true); w[p4] = (unsigned)q; }
        *(u32x4*)(v8t + ((size_t)(b * NKV + kvh) * 64 + lane) * SEQ + tile * 64 + 16 * c) = (u32x4){w[0], w[1], w[2], w[3]};
    }
}
__device__ __forceinline__ void ph_rope_table(float* rope, int gt, int nt) {
    for (int i = gt; i < 192 * 16; i += nt) { const int r = i >> 4, j = i & 15; const float inv = powf(10000.f, -(float)j / 16.f); const float ang = (float)(r < 128 ? r : r - 128) * inv;
        float sn, cs; sincosf(ang, &sn, &cs); rope[r * 32 + j] = cs; rope[r * 32 + 16 + j] = sn; }
}
__device__ __forceinline__ void ph_conv(const bf16_t* proj, const float* __restrict__ cw, const float* __restrict__ cb, bf16_t* xbc, int gt, int nt) {
    for (int i = gt; i < (M / 8) * 128; i += nt) {
        const int rbk = i >> 7, c0 = (i & 127) * 8, m0 = rbk * 8, t0 = m0 & (SEQ - 1);
        u32x4 raw[12];
#pragma unroll
        for (int r = 0; r < 12; ++r) { const int tt = t0 + r - 2; raw[r] = (tt >= 0 && tt < SEQ) ? *(const u32x4*)(proj + (size_t)(m0 + r - 2) * NPROJ_PAD + C_XBC + c0) : (u32x4){0u, 0u, 0u, 0u}; }
        float w[5][8];
#pragma unroll
        for (int j = 0; j < 5; ++j) { const f32x4 w0 = *(const f32x4*)(cw + j * 1024 + c0), w1 = *(const f32x4*)(cw + j * 1024 + c0 + 4); w[j][0] = w0.x; w[j][1] = w0.y; w[j][2] = w0.z; w[j][3] = w0.w; w[j][4] = w1.x; w[j][5] = w1.y; w[j][6] = w1.z; w[j][7] = w1.w; }
        const f32x4 b0 = *(const f32x4*)(cb + c0), b1 = *(const f32x4*)(cb + c0 + 4); const float bias[8] = {b0.x, b0.y, b0.z, b0.w, b1.x, b1.y, b1.z, b1.w};
#pragma unroll
        for (int r = 0; r < 8; ++r) { float acc[8]; typedef float f32x2c __attribute__((ext_vector_type(2))); f32x2c a2[4];
#pragma unroll
            for (int k = 0; k < 4; ++k) a2[k] = (f32x2c){bias[2 * k], bias[2 * k + 1]};
#pragma unroll
            for (int j = 0; j < 5; ++j) { const unsigned ww[4] = {raw[r + j].x, raw[r + j].y, raw[r + j].z, raw[r + j].w};
#pragma unroll
                for (int k = 0; k < 4; ++k) a2[k] += (f32x2c){__uint_as_float(ww[k] << 16), __uint_as_float(ww[k] & 0xffff0000u)} * (f32x2c){w[j][2 * k], w[j][2 * k + 1]}; }
#pragma unroll
            for (int k = 0; k < 4; ++k) { acc[2 * k] = a2[k].x; acc[2 * k + 1] = a2[k].y; }
            u32x4 o; o.x = pk2(silu_f(acc[0]), silu_f(acc[1])); o.y = pk2(silu_f(acc[2]), silu_f(acc[3])); o.z = pk2(silu_f(acc[4]), silu_f(acc[5])); o.w = pk2(silu_f(acc[6]), silu_f(acc[7]));
            *(u32x4*)(xbc + (size_t)(m0 + r) * 1024 + c0) = o; }
    }
}
__device__ __forceinline__ void ph_dt(const bf16_t* __restrict__ proj, const float* __restrict__ dtb, float* __restrict__ dt, int gt, int nt) {
    for (int i = gt; i < M * 16; i += nt) { const int m = i >> 4, c = i & 15;
        const float v = bf2f(proj[(size_t)m * NPROJ_PAD + C_DT + c]) + dtb[c];
        dt[i] = fmaxf(v, 0.f) + __logf(1.f + __expf(-fabsf(v))); }
}
__device__ __forceinline__ void ph_attnnorm(bf16_t* mix, const float* __restrict__ gain, int gw, int nw, int lane) {
    const float* g = gain + lane * 8;
    for (int m0 = gw; m0 < M; m0 += 4 * nw) {
        u32x4 raw[4];
#pragma unroll
        for (int r = 0; r < 4; ++r) raw[r] = *((const u32x4*)(mix + (size_t)(m0 + r * nw) * D) + lane);
#pragma unroll
        for (int r = 0; r < 4; ++r) { const unsigned w[4] = {raw[r].x, raw[r].y, raw[r].z, raw[r].w};
            float v[8]; float s = 0.f;
#pragma unroll
            for (int k = 0; k < 4; ++k) { v[2 * k] = bf2f(w[k] & 0xffffu); v[2 * k + 1] = bf2f(w[k] >> 16); s += v[2 * k] * v[2 * k] + v[2 * k + 1] * v[2 * k + 1]; }
            const float rstd = 1.0f / sqrtf(wave_sum(s) * (1.f / 512.f) + EPS);
            u32x4 o; o.x = pk2(v[0] * rstd * g[0], v[1] * rstd * g[1]); o.y = pk2(v[2] * rstd * g[2], v[3] * rstd * g[3]); o.z = pk2(v[4] * rstd * g[4], v[5] * rstd * g[5]); o.w = pk2(v[6] * rstd * g[6], v[7] * rstd * g[7]);
            *((u32x4*)(mix + (size_t)(m0 + r * nw) * D) + lane) = o; }
    }
}
__device__ __forceinline__ void ph_attnnorm_i8(const bf16_t* mix, const float* __restrict__ gain, unsigned char* mixq, float* sM, int gw, int nw, int lane) {
    for (int m = gw; m < M; m += nw) {
        const u32x4 ra = *((const u32x4*)(mix + (size_t)m * D) + lane), rs = *((const u32x4*)(mix + (size_t)m * D + 512) + lane);
        const unsigned wa[4] = {ra.x, ra.y, ra.z, ra.w}, ws_[4] = {rs.x, rs.y, rs.z, rs.w};
        float a[8], b[8]; float s = 0.f;
#pragma unroll
        for (int k = 0; k < 4; ++k) { a[2 * k] = bf2f(wa[k] & 0xffffu); a[2 * k + 1] = bf2f(wa[k] >> 16); b[2 * k] = bf2f(ws_[k] & 0xffffu); b[2 * k + 1] = bf2f(ws_[k] >> 16); s += a[2 * k] * a[2 * k] + a[2 * k + 1] * a[2 * k + 1]; }
        const float rstd = 1.0f / sqrtf(wave_sum(s) * (1.f / 512.f) + EPS);
        const float* g = gain + lane * 8; float mx = 0.f;
#pragma unroll
        for (int k = 0; k < 8; ++k) { a[k] *= rstd * g[k]; mx = fmaxf(mx, fmaxf(fabsf(a[k]), fabsf(b[k]))); }
        mx = wave_max(mx); const float inv = mx > 0.f ? 127.f / mx : 0.f;
        u32x2 qa, qb; qa.x = q4_i8(a[0], a[1], a[2], a[3], inv); qa.y = q4_i8(a[4], a[5], a[6], a[7], inv); qb.x = q4_i8(b[0], b[1], b[2], b[3], inv); qb.y = q4_i8(b[4], b[5], b[6], b[7], inv);
        *((u32x2*)(mixq + (size_t)m * D) + lane) = qa; *((u32x2*)(mixq + (size_t)m * D + 512) + lane) = qb;
        if (lane == 0) sM[m] = mx * (1.f / 127.f);
    }
}
__device__ __forceinline__ void ph_scan(const bf16_t* stf, const bf16_t* stb, bf16_t* prvf, bf16_t* prvb, const float* decf, const float* decb, int gt, int nt) {
    typedef float f32x2 __attribute__((ext_vector_type(2)));
    for (int i = gt; i < 2 * BATCH * SH * 4096; i += nt) {
        const int dir = i >> 16, rest = i & 65535, b = rest >> 15, h = (rest >> 12) & 7, pn = (rest & 4095) * 2;
        const bf16_t* st = dir ? stb : stf; bf16_t* pv = dir ? prvb : prvf; const float* dec = dir ? decb : decf;
        float c0 = 0.f, c1 = 0.f;
#pragma unroll 1
        for (int cb = 0; cb < NCHUNK; cb += 32) {
            unsigned v[32]; float dv[32];
#pragma unroll
            for (int k = 0; k < 32; ++k) { const int c = dir ? (NCHUNK - 1 - cb - k) : (cb + k); const int u = (b * NCHUNK + c) * 8 + h; v[k] = *(const unsigned*)(st + (size_t)u * 8192 + pn); dv[k] = dec[u]; }
#pragma unroll
            for (int k = 0; k < 32; ++k) { const int c = dir ? (NCHUNK - 1 - cb - k) : (cb + k); const int u = (b * NCHUNK + c) * 8 + h;
                *(unsigned*)(pv + (size_t)u * 8192 + pn) = pk2(c0, c1); c0 = c0 * dv[k] + bf2f(v[k] & 0xffffu); c1 = c1 * dv[k] + bf2f(v[k] >> 16); }
        }
    }
}
__device__ __forceinline__ void ph_ssdnorm(const float* __restrict__ ytmp, const float* __restrict__ gain, bf16_t* __restrict__ mix, int gw, int nw, int lane) {
    for (int i = gw; i < M * 2; i += nw) { const int m = i >> 1, g = i & 1;
        const f32x4 v = *((const f32x4*)(ytmp + (size_t)m * 512 + g * 256) + lane);
        const float rstd = 1.0f / sqrtf(wave_sum(v.x * v.x + v.y * v.y + v.z * v.z + v.w * v.w) * (1.f / 256.f) + EPS);
        const f32x4 gn = *((const f32x4*)(gain + g * 256) + lane);
        u32x2 o; o.x = pk2(v.x * rstd * gn.x, v.y * rstd * gn.y); o.y = pk2(v.z * rstd * gn.z, v.w * rstd * gn.w);
        *((u32x2*)(mix + (size_t)m * D + 512 + g * 256) + lane) = o; }
}
__device__ __forceinline__ void ph_router_table(const float* w_router, const float* norm_ffn, bf16_t* wrh, bf16_t* wrl, int gt, int nt) {
    for (int i = gt; i < DEPTH * NE * D; i += nt) { const int l = i / (NE * D), r = i % (NE * D), e = r >> 10, k = r & 1023;
        const float w = norm_ffn[l * D + k] * w_router[((size_t)l * D + k) * NE + e]; const unsigned hi = f2bf(w); const unsigned lo = f2bf(w - bf2f(hi));
        wrh[i] = (bf16_t)hi; wrl[i] = (bf16_t)lo; }
}
__device__ __forceinline__ void prefetch_region(const void* base, size_t bytes, int part, int nparts, int lane) {
    const size_t per = (bytes / nparts) & ~(size_t)16383;
    const u32x4* p = (const u32x4*)((const char*)base + (size_t)part * per) + lane;
    for (size_t o = 0; o < per; o += 16384) { u32x4 v[16];
#pragma unroll
        for (int i = 0; i < 16; ++i) v[i] = p[(o >> 4) + i * 64];
#pragma unroll
        for (int i = 0; i < 16; ++i) asm volatile("" :: "v"(v[i])); }
}
__device__ __forceinline__ void ph_router(const bf16_t* x1, const float* __restrict__ gain, const bf16_t* wrh, const bf16_t* wrl, const float* __restrict__ br, bf16_t* hmoe,
                                          int* cnt, int* seg, int* tke, float* tkw, int* tkr, LAS unsigned char* lds, int bx, int G, const int tid, const int skip = 0, const void* pf0 = nullptr, size_t pfb0 = 0, const void* pf1 = nullptr, size_t pfb1 = 0) {
    const int lane = tid & 63, wave = __builtin_amdgcn_readfirstlane(tid >> 6), g4 = lane >> 4, fr = lane & 15;
    LAS float* part = (LAS float*)lds; LAS float* ssqp = (LAS float*)(lds + 65536); LAS float* lt = (LAS float*)(lds + 67584); LAS float* rstdv = (LAS float*)(lds + 76032);
    for (int rb = bx; rb < M / 64; rb += G) {
        const int k0 = wave * 128 + 8 * g4;
        const bf16_t* xp = x1 + (size_t)(rb * 64 + fr) * D + k0;
        const bf16_t* bhp = wrh + (size_t)fr * D + k0; const bf16_t* blp = wrl + (size_t)fr * D + k0;
        u32x4 xf[4][4];
#pragma unroll
        for (int ks = 0; ks < 4; ++ks)
#pragma unroll
            for (int t = 0; t < 4; ++t) xf[ks][t] = *(const u32x4*)(xp + (size_t)t * 16 * D + 32 * ks);
        f32x4 acc[4][2]; float ss[4];
#pragma unroll
        for (int t = 0; t < 4; ++t) { acc[t][0] = (f32x4){0.f, 0.f, 0.f, 0.f}; acc[t][1] = acc[t][0]; ss[t] = 0.f; }
        if (!(skip & 1)) {
#pragma unroll
        for (int ks = 0; ks < 4; ++ks) {
            const bf16x8 bh0 = *(const bf16x8*)(bhp + 32 * ks), bh1 = *(const bf16x8*)(bhp + 16 * D + 32 * ks), bl0 = *(const bf16x8*)(blp + 32 * ks), bl1 = *(const bf16x8*)(blp + 16 * D + 32 * ks);
#pragma unroll
            for (int t = 0; t < 4; ++t) { const bf16x8 ah = __builtin_bit_cast(bf16x8, xf[ks][t]);
                acc[t][0] = __builtin_amdgcn_mfma_f32_16x16x32_bf16(ah, bh0, acc[t][0], 0, 0, 0); acc[t][0] = __builtin_amdgcn_mfma_f32_16x16x32_bf16(ah, bl0, acc[t][0], 0, 0, 0);
                acc[t][1] = __builtin_amdgcn_mfma_f32_16x16x32_bf16(ah, bh1, acc[t][1], 0, 0, 0); acc[t][1] = __builtin_amdgcn_mfma_f32_16x16x32_bf16(ah, bl1, acc[t][1], 0, 0, 0);
                const unsigned w_[4] = {xf[ks][t].x, xf[ks][t].y, xf[ks][t].z, xf[ks][t].w};
#pragma unroll
                for (int k = 0; k < 4; ++k) { const float a = __uint_as_float(w_[k] << 16), b = __uint_as_float(w_[k] & 0xffff0000u); ss[t] += a * a + b * b; } }
        } }
#pragma unroll
        for (int t = 0; t < 4; ++t) { ss[t] += __shfl_xor(ss[t], 16); ss[t] += __shfl_xor(ss[t], 32);
            LAS float* pp = part + ((wave * 4 + t) * 64 + lane) * 8; *(LAS f32x4*)pp = acc[t][0]; *(LAS f32x4*)(pp + 4) = acc[t][1];
            if (g4 == 0) ssqp[wave * 64 + t * 16 + fr] = ss[t]; }
        __syncthreads();
        {
            const int t = wave & 3, h = wave >> 2; f32x4 a = (f32x4){0.f, 0.f, 0.f, 0.f};
#pragma unroll
            for (int src = 0; src < 8; ++src) a += *(const LAS f32x4*)(part + ((src * 4 + t) * 64 + lane) * 8 + h * 4);
            const float bb = br[16 * h + fr];
#pragma unroll
            for (int j = 0; j < 4; ++j) { const int r = t * 16 + 4 * g4 + j; float sq = 0.f;
#pragma unroll
                for (int src = 0; src < 8; ++src) sq += ssqp[src * 64 + r];
                const float rs = 1.0f / sqrtf(sq * (1.f / D) + EPS);
                lt[r * 33 + 16 * h + fr] = a[j] * rs + bb; if (h == 0 && fr == 0) rstdv[r] = rs; }
        }
        __syncthreads();
        if (tid < 64 && !(skip & 2)) {
            const int m = rb * 64 + tid; float lg[32];
#pragma unroll
            for (int e = 0; e < 32; ++e) lg[e] = lt[tid * 33 + e];
            int ei[4]; float ev[4];
#pragma unroll
            for (int k = 0; k < 4; ++k) { float best = -3.0e38f; int bi = 0;
#pragma unroll
                for (int e = 0; e < 32; ++e) if (lg[e] > best) { best = lg[e]; bi = e; }
                ei[k] = bi; ev[k] = best;
#pragma unroll
                for (int e = 0; e < 32; ++e) if (e == bi) lg[e] = -3.0e38f; }
            const float p1 = __expf(ev[1] - ev[0]), p2 = __expf(ev[2] - ev[0]), p3 = __expf(ev[3] - ev[0]); const float inv = __builtin_amdgcn_rcpf(1.f + p1 + p2 + p3);
            const float wv[4] = {inv, p1 * inv, p2 * inv, p3 * inv};
            LAS int* lcnt = (LAS int*)(lds + 76288); LAS int* lbase = lcnt + 32;
            if (tid < 32) lcnt[tid] = 0;
            asm volatile("s_waitcnt lgkmcnt(0)" ::: "memory");
            int lr[4];
#pragma unroll
            for (int k = 0; k < 4; ++k) lr[k] = __hip_atomic_fetch_add(lcnt + ei[k], 1, __ATOMIC_RELAXED, __HIP_MEMORY_SCOPE_WORKGROUP);
            asm volatile("s_waitcnt lgkmcnt(0)" ::: "memory");
            if (tid < 32) { const int c = lcnt[tid]; lbase[tid] = c > 0 ? atomicAdd(&cnt[tid], c) : 0; }
            asm volatile("s_waitcnt vmcnt(0) lgkmcnt(0)" ::: "memory");
#pragma unroll
            for (int k = 0; k < 4; ++k) { const int e = ei[k]; const int rank = lbase[e] + lr[k]; seg[e * M + rank] = m; tke[m * 4 + k] = e; tkw[m * 4 + k] = wv[k]; tkr[m * 4 + k] = rank; }
        }
        if (!(skip & 4)) {
#pragma unroll
        for (int ks = 0; ks < 4; ++ks) { const float* gp = gain + wave * 128 + 32 * ks + 8 * g4; const f32x4 ga = *(const f32x4*)gp, gb = *(const f32x4*)(gp + 4);
#pragma unroll
            for (int t = 0; t < 4; ++t) { const size_t m = (size_t)rb * 64 + t * 16 + fr; const unsigned w_[4] = {xf[ks][t].x, xf[ks][t].y, xf[ks][t].z, xf[ks][t].w};
                float v[8];
#pragma unroll
                for (int k = 0; k < 4; ++k) { v[2 * k] = __uint_as_float(w_[k] << 16); v[2 * k + 1] = __uint_as_float(w_[k] & 0xffff0000u); }
#if MOE_F8
                const float rs = 16.f * rstdv[t * 16 + fr];
                int w0 = __builtin_amdgcn_cvt_pk_fp8_f32(v[0] * rs * ga.x, v[1] * rs * ga.y, UNDEF32(), false); w0 = __builtin_amdgcn_cvt_pk_fp8_f32(v[2] * rs * ga.z, v[3] * rs * ga.w, w0, true);
                int w1 = __builtin_amdgcn_cvt_pk_fp8_f32(v[4] * rs * gb.x, v[5] * rs * gb.y, UNDEF32(), false); w1 = __builtin_amdgcn_cvt_pk_fp8_f32(v[6] * rs * gb.z, v[7] * rs * gb.w, w1, true);
                *(u32x2*)((unsigned char*)hmoe + m * D + wave * 128 + 32 * ks + 8 * g4) = (u32x2){(unsigned)w0, (unsigned)w1};
#else
                const float rs = rstdv[t * 16 + fr];
                *(u32x4*)(hmoe + m * D + wave * 128 + 32 * ks + 8 * g4) = (u32x4){pk2(v[0] * rs * ga.x, v[1] * rs * ga.y), pk2(v[2] * rs * ga.z, v[3] * rs * ga.w), pk2(v[4] * rs * gb.x, v[5] * rs * gb.y), pk2(v[6] * rs * gb.z, v[7] * rs * gb.w)};
#endif
            } } }
        if (pf0 && wave > 0 && rb == bx) { prefetch_region(pf0, pfb0, bx * 7 + wave - 1, G * 7, lane); prefetch_region(pf1, pfb1, bx * 7 + wave - 1, G * 7, lane); }
        __syncthreads();
    }
}
typedef float f32x2v __attribute__((ext_vector_type(2)));
__device__ __forceinline__ void ph_combine(const bf16_t* xin, bf16_t* xout, float* out, const bf16_t* ys, const int* cnt, const int* tke, const float* tkw, const int* tkr, LAS int* pstart, const float* gain_next, bf16_t* hn, float* sA,
                                           int gw, int nw, int lane, int tid) {
    if (tid == 0) { int ps = 0; for (int e = 0; e < NE; ++e) { pstart[e] = ps; ps += ((cnt[e] + 255) / 256) * 256; } }
    __syncthreads();
    for (int m = gw; m < M; m += nw) {
        const u32x2* xr = (const u32x2*)(xin + (size_t)m * D) + lane; f32x4 acc[4];
#pragma unroll
        for (int j = 0; j < 4; ++j) { const u32x2 r = xr[64 * j]; acc[j] = (f32x4){__uint_as_float(r.x << 16), __uint_as_float(r.x & 0xffff0000u), __uint_as_float(r.y << 16), __uint_as_float(r.y & 0xffff0000u)}; }
#pragma unroll
        for (int k = 0; k < 4; ++k) { const int e = tke[m * 4 + k]; const float w = tkw[m * 4 + k]; const size_t row = (size_t)pstart[e] + tkr[m * 4 + k];
#if YS_F8
            const unsigned* yr = (const unsigned*)((const unsigned char*)ys + row * D) + lane; const float w8 = w * 0.125f;
#pragma unroll
            for (int j = 0; j < 4; ++j) { const int r = (int)yr[64 * j]; const f32x2v lo = __builtin_amdgcn_cvt_pk_f32_fp8(r, false), hi = __builtin_amdgcn_cvt_pk_f32_fp8(r, true);
                acc[j].x += w8 * lo.x; acc[j].y += w8 * lo.y; acc[j].z += w8 * hi.x; acc[j].w += w8 * hi.y; } }
#else
            const u32x2* yr = (const u32x2*)(ys + row * D) + lane;
#pragma unroll
            for (int j = 0; j < 4; ++j) { const u32x2 r = yr[64 * j]; acc[j].x += w * bf2f(r.x & 0xffffu); acc[j].y += w * bf2f(r.x >> 16); acc[j].z += w * bf2f(r.y & 0xffffu); acc[j].w += w * bf2f(r.y >> 16); } }
#endif
        float s = 0.f;
#pragma unroll
        for (int j = 0; j < 4; ++j) { if (xout) { u32x2 w; w.x = pk2(acc[j].x, acc[j].y); w.y = pk2(acc[j].z, acc[j].w); ((u32x2*)(xout + (size_t)m * D) + lane)[64 * j] = w; } else ((f32x4*)(out + (size_t)m * D) + lane)[64 * j] = acc[j];
            s += acc[j].x * acc[j].x + acc[j].y * acc[j].y + acc[j].z * acc[j].z + acc[j].w * acc[j].w; }
        if (gain_next) {
            const float rstd = 1.0f / sqrtf(wave_sum(s) * (1.f / D) + EPS);
#if PROJ_I8
            float mx = 0.f;
#pragma unroll
            for (int j = 0; j < 4; ++j) { const f32x4 g = ((const f32x4*)gain_next)[64 * j + lane]; acc[j].x *= rstd * g.x; acc[j].y *= rstd * g.y; acc[j].z *= rstd * g.z; acc[j].w *= rstd * g.w;
                mx = fmaxf(fmaxf(mx, fmaxf(fabsf(acc[j].x), fabsf(acc[j].y))), fmaxf(fabsf(acc[j].z), fabsf(acc[j].w))); }
            mx = wave_max(mx); const float inv = mx > 0.f ? 127.f / mx : 0.f;
            unsigned* o = (unsigned*)((unsigned char*)hn + (size_t)m * D) + lane;
#pragma unroll
            for (int j = 0; j < 4; ++j) o[64 * j] = q4_i8(acc[j].x, acc[j].y, acc[j].z, acc[j].w, inv);
            if (lane == 0) sA[m] = mx * (1.f / 127.f);
#else
            u32x2* o = (u32x2*)(hn + (size_t)m * D) + lane;
#pragma unroll
            for (int j = 0; j < 4; ++j) { const f32x4 g = ((const f32x4*)gain_next)[64 * j + lane]; u32x2 w; w.x = pk2(acc[j].x * rstd * g.x, acc[j].y * rstd * g.y); w.y = pk2(acc[j].z * rstd * g.z, acc[j].w * rstd * g.w); o[64 * j] = w; }
#endif
        }
    }
    __syncthreads();
}
namespace g8 {
constexpr int BM = 256, BK = 64, HALF = 128, HTB = HALF * BK * 2, STAGE_BYTES = 8 * HTB, NXCD = 8, WGM = 8;
constexpr int GK = 1024;
#ifndef ACT_SPREAD
#define ACT_SPREAD 0
#endif
#ifndef EXPERT_GROUP4
#define EXPERT_GROUP4 0
#endif
#ifndef EXPERT_XCD_ORDER
#define EXPERT_XCD_ORDER 0
#endif
#ifndef F8_SCALE
#define F8_SCALE 0
#endif
__device__ __forceinline__ int lds_byte(int r, int c) { const int st = (r >> 4) * 2 + (c >> 5), rr = r & 15, cc = c & 31, ob = rr * 64 + cc * 2; return st * 1024 + (ob ^ (((ob >> 9) & 1) << 5)); }
__device__ __forceinline__ int lds_byte_b(int r, int cb) { const int st = (r >> 4) * 2 + (cb >> 6), rr = r & 15, ob = rr * 64 + (cb & 63); return st * 1024 + (ob ^ (((ob >> 9) & 1) << 5)); }
#ifndef G8_F8_SWZ4
#define G8_F8_SWZ4 1
#endif
__device__ __forceinline__ int lds_byte_b8(int r, int cb) { const int st = (r >> 4) * 2 + (cb >> 6), rr = r & 15, ob = rr * 64 + (cb & 63); return st * 1024 + (ob ^ (((ob >> 9) & 1) << (G8_F8_SWZ4 ? 4 : 5))); }
__device__ __forceinline__ void stage_rc8(int b, int& R, int& C) { const int st = b / 1024, sb = b % 1024, swz = sb ^ (((sb >> 9) & 1) << (G8_F8_SWZ4 ? 4 : 5)); R = (st >> 1) * 16 + swz / 64; C = (st & 1) * 32 + (swz % 64) / 2; }
typedef int v8i __attribute__((ext_vector_type(8)));
typedef int i32x4 __attribute__((ext_vector_type(4)));
__device__ __forceinline__ void stage_rc(int b, int& R, int& C) { const int st = b / 1024, sb = b % 1024, swz = sb ^ (((sb >> 9) & 1) << 5); R = (st >> 1) * 16 + swz / 64; C = (st & 1) * 32 + (swz % 64) / 2; }
__device__ __forceinline__ int perm32(int rho) { const int n = rho >> 4, i = rho & 15; return 8 * (i >> 2) + 4 * n + (i & 3); }
__device__ __forceinline__ unsigned cvt_pk_bf16(float lo, float hi) { unsigned r; asm volatile("v_cvt_pk_bf16_f32 %0, %1, %2" : "=v"(r) : "v"(lo), "v"(hi)); return r; }

struct Unit { int pm, pn, e, mt, ce, half, ord; };

__device__ __forceinline__ bool tail_split(int i, int G, int c, int total, int& U, int& half) {
    const int fullr = total / G, rem = total - fullr * G; const bool split = rem > 0 && 2 * rem <= G; const int L = i * G + c; half = 0;
    if (!split || L < fullr * G) { if (L >= total) return false; U = L; return true; }
    const int t2 = L - fullr * G; if (t2 >= 2 * rem) return false; U = fullr * G + (t2 >> 1); half = 1 + (t2 & 1); return true;
}
struct DenseOrder {
    static constexpr bool BTILED = false;
    int nM, nN, nwg, G, c, esz; const void* Bt;
    __device__ void init(int M_, int N_, int G_, int c_, const void* Bt_, int esz_ = 2) { nM = M_ / BM; nN = N_ / BM; nwg = nM * nN; G = G_; c = c_; Bt = Bt_; esz = esz_; }
    __device__ __forceinline__ bool next(int i, Unit& u) const {
        int U, hf; if (!tail_split(i, G, c, nwg, U, hf)) return false;
        int wgid = U; u.half = hf; u.ord = i; { const int q = nwg / NXCD, r = nwg % NXCD, xcd = wgid % NXCD, off = wgid / NXCD; wgid = (xcd < r ? xcd * (q + 1) : r * (q + 1) + (xcd - r) * q) + off; }
        const int nig = WGM * nN, gid = wgid / nig, fm = gid * WGM, gsz = (nM - fm) < WGM ? (nM - fm) : WGM;
        u.pm = fm + ((wgid % nig) % gsz); u.pn = (wgid % nig) / gsz; u.e = 0; u.mt = 0; u.ce = 0; return true;
    }
    __device__ __forceinline__ unsigned arow(const Unit& u, int r) const { return (unsigned)(u.pm * BM + (u.half ? (u.half - 1) * HALF + (r & (HALF - 1)) : r)); }
    __device__ __forceinline__ unsigned aoff(const Unit& u, int r, int KB_) const { return arow(u, r) * (unsigned)KB_; }
    __device__ __forceinline__ size_t akstep() const { return 128; }
    __device__ __forceinline__ const char* bbase(const Unit& u) const { return (const char*)Bt + (size_t)u.pn * BM * GK * esz; }
    __device__ __forceinline__ void preload(LAS unsigned char*, int) const {}
};
struct ExpertOrder {
    static constexpr bool BTILED = WEXP_TILED && MOE_F8;
    const LAS int* tab; int NT, MG, G, c; const void* Bt; size_t bstride; const int* seg; bool gather; int esz; LAS unsigned short* gidx;
    __device__ __forceinline__ bool next(int i, Unit& u) const {
#if EXPERT_XCD_ORDER
        const int x = c & 7, S = G >> 3; int L, hf; if (!tail_split(i, S, c >> 3, tab[448 + 8 * x + 4], L, hf)) return false;
        int q = 0;
#pragma unroll
        for (int k = 1; k < 4; ++k) q += (tab[448 + 8 * x + k] <= L) ? 1 : 0;
        const int e = x + 8 * q, r = L - tab[448 + 8 * x + q], ce = tab[e], nt_e = (ce + 255) >> 8;
        const int per = MG * NT, grp = r / per, w = r - grp * per;
        const int gsz = (nt_e - grp * MG) < MG ? (nt_e - grp * MG) : MG;
        u.mt = grp * MG + (w % gsz); u.pn = w / gsz; u.e = e; u.ce = ce; u.pm = tab[32 + e] + u.mt; u.half = hf; u.ord = i; return true;
#else
        const int cc = (G & 7) ? c : (c & 7) * (G >> 3) + (c >> 3);
        int U, hf; if (!tail_split(i, G, cc, tab[64 + 32] * NT, U, hf)) return false;
#if EXPERT_GROUP4
        const int T_ = tab[64 + 32], per = 4 * NT, grp = U / per, w = U - grp * per, gsz = (T_ - 4 * grp) < 4 ? (T_ - 4 * grp) : 4;
        const int tile = 4 * grp + (w % gsz); u.pn = w / gsz; u.half = hf; u.ord = i;
#else
        const int tile = U / NT; u.pn = U - tile * NT; u.half = hf; u.ord = i;
#endif
        const int e = tab[128 + tile];
        u.e = e; u.mt = tile - tab[64 + e]; u.pm = tab[32 + e] + u.mt; u.ce = tab[e];
        if (u.half == 0 && u.ce - u.mt * BM <= HALF) u.half = 1;
        return true;
#endif
    }
    __device__ __forceinline__ unsigned arow_g(const Unit& u, int r) const {
        const int rr = u.half ? (u.half - 1) * HALF + (r & (HALF - 1)) : r;
#if ACT_SPREAD
        if (!gather) return (unsigned)(rr * (ACT_ROWS / BM) + u.pm);
#else
        if (!gather) return (unsigned)(u.pm * BM + rr);
#endif
        const int slot = u.mt * BM + rr; return slot < u.ce ? (unsigned)seg[u.e * M + slot] : 0u;
    }
    __device__ __forceinline__ unsigned arow(const Unit& u, int r) const {
        if (gather && u.ord < MAXORD) return (unsigned)gidx[u.ord * 256 + r];
        return arow_g(u, r);
    }
    __device__ __forceinline__ bool atiled() const { return ACT_TILED && MOE_F8 && !gather; }
    __device__ __forceinline__ unsigned aoff(const Unit& u, int r, int KB_) const {
        if (atiled()) { const int rr = u.half ? (u.half - 1) * HALF + (r & (HALF - 1)) : r; return (unsigned)((u.pm * 2 + (rr >> 7)) * 131072 + (rr & 127) * 128); }
        return arow(u, r) * (unsigned)KB_; }
    __device__ __forceinline__ size_t akstep() const { return atiled() ? (size_t)16384 : (size_t)128; }
    __device__ __forceinline__ void preload(LAS unsigned char* ldsbase, int tid) const {
        if (!gather) return;
        unsigned v_[MAXORD]; bool ok_[MAXORD];
#pragma unroll
        for (int i = 0; i < MAXORD; ++i) { Unit u; ok_[i] = next(i, u); v_[i] = (ok_[i] && tid < 256) ? arow_g(u, tid) : 0u; }
#pragma unroll
        for (int i = 0; i < MAXORD; ++i) if (ok_[i] && tid < 256) gidx[i * 256 + tid] = (unsigned short)v_[i];
    }
    __device__ __forceinline__ const char* bbase(const Unit& u) const { return (const char*)Bt + ((size_t)u.e * bstride + (size_t)u.pn * BM * GK) * esz; }
};
__device__ __forceinline__ void expert_table(const int* cnt, LAS int* tab, int NT, const int tid) {
    if (tid < 64) {
        const int c = tid < NE ? (int)__hip_atomic_load(cnt + tid, __ATOMIC_RELAXED, __HIP_MEMORY_SCOPE_AGENT) : 0; const int t = (c + 255) >> 8; int ps = t;
#pragma unroll
        for (int o = 1; o < 32; o <<= 1) { const int v = __shfl_up(ps, o); if (tid >= o) ps += v; }
        if (tid < NE) { tab[tid] = c; tab[32 + tid] = ps - t; tab[64 + tid] = ps - t; }
        if (tid == NE - 1) tab[64 + 32] = ps; }
    __syncthreads();
    if (tid < NE) { const int t0 = tab[64 + tid], t1 = tab[64 + tid + 1]; for (int t = t0; t < t1; ++t) tab[128 + t] = tid; }
    if (tid >= 64 && tid < 72) { const int x = tid - 64; int t = 0; for (int q = 0; q < 4; ++q) { tab[448 + 8 * x + q] = t; t += ((tab[x + 8 * q] + 255) >> 8) * NT; } tab[448 + 8 * x + 4] = t; }
    __syncthreads();
}

struct EpiProj {
    static constexpr bool PERM = true;
    template <class Sched> __device__ __forceinline__ void preload(const Sched&, int) const {}
    bf16_t* O; int ldc;
    __device__ __forceinline__ void operator()(const f32x4 (&acc)[2][2][4][2], const Unit& u, int wr, int wc, int fr, int fq) const {
        const int nai = u.half ? 1 : 2; const int row0 = u.pm * BM + (u.half == 2 ? HALF : 0) + wr * 64 + fr, col0 = u.pn * BM + wc * 32 + 8 * fq;
#pragma unroll
        for (int ai = 0; ai < 2; ++ai) if (ai < nai)
#pragma unroll
            for (int m = 0; m < 4; ++m) { bf16_t* rowp = O + (size_t)(row0 + ai * HALF + m * 16) * ldc + col0;
#pragma unroll
                for (int bj = 0; bj < 2; ++bj) { const f32x4 v0 = acc[ai][bj][m][0], v1 = acc[ai][bj][m][1];
                    u32x4 w; w.x = cvt_pk_bf16(v0[0], v0[1]); w.y = cvt_pk_bf16(v0[2], v0[3]); w.z = cvt_pk_bf16(v1[0], v1[1]); w.w = cvt_pk_bf16(v1[2], v1[3]);
                    *(u32x4*)(rowp + bj * HALF) = w; } }
    }
};
struct EpiProjI8 {
    static constexpr bool PERM = true;
    bf16_t* O; int ldc; const float* sA; const unsigned* cmax; LAS float* lb;
    template <class Sched> __device__ __forceinline__ void preload(const Sched& S, int tid) const {
        float v_[MAXORD / 2]; bool ok_[MAXORD / 2];
#pragma unroll
        for (int i = 0; i < MAXORD / 2; ++i) { Unit u; ok_[i] = S.next(i, u); v_[i] = !ok_[i] ? 0.f : tid < 256 ? sA[S.arow(u, tid)] : __uint_as_float(cmax[u.pn * BM + tid - 256]) * (1.f / 127.f); }
#pragma unroll
        for (int i = 0; i < MAXORD / 2; ++i) if (ok_[i]) lb[i * 512 + tid] = v_[i];
    }
    __device__ __forceinline__ void operator()(const f32x4 (&acc)[2][2][4][2], const Unit& u, int wr, int wc, int fr, int fq) const {
        const int nai = u.half ? 1 : 2; const int row0 = u.pm * BM + (u.half == 2 ? HALF : 0) + wr * 64 + fr, col0 = u.pn * BM + wc * 32 + 8 * fq;
        const LAS float* l = lb + u.ord * 512;
        f32x4 cs[2][2];
#pragma unroll
        for (int bj = 0; bj < 2; ++bj)
#pragma unroll
            for (int n = 0; n < 2; ++n) cs[bj][n] = *(const LAS f32x4*)(l + 256 + wc * 32 + 8 * fq + bj * HALF + 4 * n);
#pragma unroll
        for (int ai = 0; ai < 2; ++ai) if (ai < nai)
#pragma unroll
            for (int m = 0; m < 4; ++m) { bf16_t* rowp = O + (size_t)(row0 + ai * HALF + m * 16) * ldc + col0; const float rs = l[ai * HALF + wr * 64 + m * 16 + fr];
#pragma unroll
                for (int bj = 0; bj < 2; ++bj) { const i32x4 a0 = __builtin_bit_cast(i32x4, acc[ai][bj][m][0]), a1 = __builtin_bit_cast(i32x4, acc[ai][bj][m][1]);
                    const f32x4 v0 = __builtin_convertvector(a0, f32x4) * rs * cs[bj][0], v1 = __builtin_convertvector(a1, f32x4) * rs * cs[bj][1];
                    u32x4 w; w.x = cvt_pk_bf16(v0[0], v0[1]); w.y = cvt_pk_bf16(v0[2], v0[3]); w.z = cvt_pk_bf16(v1[0], v1[1]); w.w = cvt_pk_bf16(v1[2], v1[3]);
                    st16_wt(rowp + bj * HALF, w); } }
    }
};
template <bool XF32> struct EpiResidB {
    static constexpr bool PERM = true;
    const float* ssq; LAS float* lb;
    template <class Sched> __device__ __forceinline__ void preload(const Sched& S, int tid) const {
        if (!ssq) return;
        for (int i = 0; i < MAXORD / 2; ++i) { Unit u; if (!S.next(i, u)) break;
            if (tid < 256) { const float* p = ssq + (size_t)S.arow(u, tid) * 8; const f32x4 a = *(const f32x4*)p, b = *(const f32x4*)(p + 4);
                lb[i * 256 + tid] = 1.0f / sqrtf(((a.x + a.y) + (a.z + a.w) + (b.x + b.y) + (b.z + b.w)) * (1.f / 512.f) + EPS); } }
    }
    __device__ __forceinline__ float rowscale(const Unit& u, int rlocal) const { return lb[u.ord * 256 + rlocal]; }
    const void* xin; bf16_t* out;
    __device__ __forceinline__ void operator()(const f32x4 (&acc)[2][2][4][2], const Unit& u, int wr, int wc, int fr, int fq) const {
        const int nai = u.half ? 1 : 2; const int row0 = u.pm * BM + (u.half == 2 ? HALF : 0) + wr * 64 + fr, col0 = u.pn * BM + wc * 32 + 8 * fq;
#pragma unroll
        for (int ai = 0; ai < 2; ++ai) if (ai < nai)
#pragma unroll
            for (int m = 0; m < 4; ++m) { const size_t off = (size_t)(row0 + ai * HALF + m * 16) * D + col0;
#pragma unroll
                for (int bj = 0; bj < 2; ++bj) { f32x4 v0 = acc[ai][bj][m][0], v1 = acc[ai][bj][m][1];
                    if constexpr (XF32) { const float* xp = (const float*)xin + off + bj * HALF; v0 += *(const f32x4*)xp; v1 += *(const f32x4*)(xp + 4); }
                    else { const u32x4 r = *(const u32x4*)((const bf16_t*)xin + off + bj * HALF);
                        v0[0] += __uint_as_float(r.x << 16); v0[1] += __uint_as_float(r.x & 0xffff0000u); v0[2] += __uint_as_float(r.y << 16); v0[3] += __uint_as_float(r.y & 0xffff0000u);
                        v1[0] += __uint_as_float(r.z << 16); v1[1] += __uint_as_float(r.z & 0xffff0000u); v1[2] += __uint_as_float(r.w << 16); v1[3] += __uint_as_float(r.w & 0xffff0000u); }
                    u32x4 w; w.x = cvt_pk_bf16(v0[0], v0[1]); w.y = cvt_pk_bf16(v0[2], v0[3]); w.z = cvt_pk_bf16(v1[0], v1[1]); w.w = cvt_pk_bf16(v1[2], v1[3]);
                    *(u32x4*)(out + off + bj * HALF) = w; } }
    }
};
struct EpiResidI8 {
    static constexpr bool PERM = false;
    const float* xin; float* out; const float* sM; const unsigned* cmax; LAS float* lb;
    template <class Sched> __device__ __forceinline__ void preload(const Sched& S, int tid) const {
        for (int i = 0; i < MAXORD / 2; ++i) { Unit u; if (!S.next(i, u)) break;
            if (tid < 256) lb[i * 512 + tid] = sM[S.arow(u, tid)]; else lb[i * 512 + tid] = __uint_as_float(cmax[u.pn * BM + tid - 256]) * (1.f / 127.f); }
    }
    __device__ __forceinline__ void operator()(const f32x4 (&acc)[2][2][4][2], const Unit& u, int wr, int wc, int fr, int fq) const {
        const int nai = u.half ? 1 : 2; const int row0 = u.pm * BM + (u.half == 2 ? HALF : 0) + wr * 64 + fr, col0 = u.pn * BM + wc * 32 + 4 * fq;
        const LAS float* l = lb + u.ord * 512;
        f32x4 cs[2][2];
#pragma unroll
        for (int bj = 0; bj < 2; ++bj)
#pragma unroll
            for (int n = 0; n < 2; ++n) cs[bj][n] = *(const LAS f32x4*)(l + 256 + wc * 32 + 4 * fq + bj * HALF + 16 * n);
#pragma unroll
        for (int ai = 0; ai < 2; ++ai) if (ai < nai)
#pragma unroll
            for (int m = 0; m < 4; ++m) { const size_t off = (size_t)(row0 + ai * HALF + m * 16) * D + col0; const float rs = l[ai * HALF + wr * 64 + m * 16 + fr];
#pragma unroll
                for (int bj = 0; bj < 2; ++bj)
#pragma unroll
                    for (int n = 0; n < 2; ++n) { const f32x4 x = *(const f32x4*)(xin + off + bj * HALF + n * 16);
                        *(f32x4*)(out + off + bj * HALF + n * 16) = x + __builtin_convertvector(__builtin_bit_cast(i32x4, acc[ai][bj][m][n]), f32x4) * rs * cs[bj][n]; } }
    }
};
struct EpiResid {
    static constexpr bool PERM = false;
    const float* ssq; LAS float* lb;
    template <class Sched> __device__ __forceinline__ void preload(const Sched& S, int tid) const {
        if (!ssq) return;
        for (int i = 0; i < MAXORD / 2; ++i) { Unit u; if (!S.next(i, u)) break;
            if (tid < 256) { const float* p = ssq + (size_t)S.arow(u, tid) * 8; const f32x4 a = *(const f32x4*)p, b = *(const f32x4*)(p + 4);
                lb[i * 256 + tid] = 1.0f / sqrtf(((a.x + a.y) + (a.z + a.w) + (b.x + b.y) + (b.z + b.w)) * (1.f / 512.f) + EPS); } }
    }
    __device__ __forceinline__ float rowscale(const Unit& u, int rlocal) const { return lb[u.ord * 256 + rlocal]; }
    const float* xin; float* out;
    __device__ __forceinline__ void operator()(const f32x4 (&acc)[2][2][4][2], const Unit& u, int wr, int wc, int fr, int fq) const {
        const int nai = u.half ? 1 : 2; const int row0 = u.pm * BM + (u.half == 2 ? HALF : 0) + wr * 64 + fr, col0 = u.pn * BM + wc * 32 + 4 * fq;
#pragma unroll
        for (int ai = 0; ai < 2; ++ai) if (ai < nai)
#pragma unroll
            for (int m = 0; m < 4; ++m) { const size_t off = (size_t)(row0 + ai * HALF + m * 16) * D + col0;
#pragma unroll
                for (int bj = 0; bj < 2; ++bj)
#pragma unroll
                    for (int n = 0; n < 2; ++n) { const f32x4 x = *(const f32x4*)(xin + off + bj * HALF + n * 16); *(f32x4*)(out + off + bj * HALF + n * 16) = x + acc[ai][bj][m][n]; } }
    }
};
__device__ __forceinline__ unsigned pk4_fp8(float a, float b, float c, float d) { int v = __builtin_amdgcn_cvt_pk_fp8_f32(a, b, UNDEF32(), false); v = __builtin_amdgcn_cvt_pk_fp8_f32(c, d, v, true); return (unsigned)v; }
template <bool F8> struct EpiGU {
    static constexpr bool PERM = true;
    void* act; const float* bg; const float* bu; LAS float* lb;
    template <class Sched> __device__ __forceinline__ void preload(const Sched& S, int tid) const {
        float v_[MAXORD]; bool ok_[MAXORD]; const int t = tid - 256;
#pragma unroll
        for (int i = 0; i < MAXORD; ++i) { Unit u; ok_[i] = S.next(i, u); v_[i] = (ok_[i] && tid >= 256) ? (t < 128 ? bg : bu)[u.e * DE + u.pn * HALF + (t & 127)] : 0.f; }
#pragma unroll
        for (int i = 0; i < MAXORD; ++i) if (ok_[i] && tid >= 256) lb[i * 256 + t] = v_[i];
    }
    __device__ __forceinline__ void operator()(const f32x4 (&acc)[2][2][4][2], const Unit& u, int wr, int wc, int fr, int fq) const {
        const int nai = u.half ? 1 : 2; const int row0 = u.pm * BM + (u.half == 2 ? HALF : 0) + wr * 64 + fr, col0 = u.pn * HALF + wc * 32 + 8 * fq;
        f32x4 g0, g1, u0, u1;
        if (u.ord < MAXORD) { const LAS float* p = lb + u.ord * 256 + wc * 32 + 8 * fq; g0 = *(const LAS f32x4*)p; g1 = *(const LAS f32x4*)(p + 4); u0 = *(const LAS f32x4*)(p + 128); u1 = *(const LAS f32x4*)(p + 132); }
        else { g0 = *(const f32x4*)(bg + u.e * DE + col0); g1 = *(const f32x4*)(bg + u.e * DE + col0 + 4); u0 = *(const f32x4*)(bu + u.e * DE + col0); u1 = *(const f32x4*)(bu + u.e * DE + col0 + 4); }
        constexpr float sc = F8 ? (1.f / 4096.f) : 1.f, os = F8 ? 4.f : 1.f;
        typedef float f32x2_ __attribute__((ext_vector_type(2)));
        constexpr float KG = -1.702f * 1.4426950408889634f, scg = sc * KG, scu = sc * os / KG, ulo = -6.f * os / KG, uhi = 8.f * os / KG;
        f32x2_ gk[4], uk[4];
#pragma unroll
        for (int jp = 0; jp < 2; ++jp) { gk[jp] = (f32x2_){g0[2 * jp], g0[2 * jp + 1]} * KG; gk[2 + jp] = (f32x2_){g1[2 * jp], g1[2 * jp + 1]} * KG;
            uk[jp] = ((f32x2_){u0[2 * jp], u0[2 * jp + 1]} + 1.f) * (os / KG); uk[2 + jp] = ((f32x2_){u1[2 * jp], u1[2 * jp + 1]} + 1.f) * (os / KG); }
#pragma unroll
        for (int ai = 0; ai < 2; ++ai) if (ai < nai)
#pragma unroll
            for (int m = 0; m < 4; ++m) {
                float r[8];
#pragma unroll
                for (int n = 0; n < 2; ++n)
#pragma unroll
                    for (int jp = 0; jp < 2; ++jp) { const f32x2_ a2 = {acc[ai][0][m][n][2 * jp], acc[ai][0][m][n][2 * jp + 1]}, b2 = {acc[ai][1][m][n][2 * jp], acc[ai][1][m][n][2 * jp + 1]};
                        f32x2_ gs = a2 * scg + gk[n * 2 + jp], uu = b2 * scu + uk[n * 2 + jp];
                        gs.x = fmaxf(gs.x, 7.f * KG); gs.y = fmaxf(gs.y, 7.f * KG);
                        uu.x = __builtin_amdgcn_fmed3f(uu.x, ulo, uhi); uu.y = __builtin_amdgcn_fmed3f(uu.y, ulo, uhi);
                        f32x2_ e = {__builtin_amdgcn_exp2f(gs.x), __builtin_amdgcn_exp2f(gs.y)}; e = e + 1.f;
                        const f32x2_ sg = {__builtin_amdgcn_rcpf(e.x), __builtin_amdgcn_rcpf(e.y)};
                        const f32x2_ rr = (gs * sg) * uu; r[n * 4 + 2 * jp] = rr.x; r[n * 4 + 2 * jp + 1] = rr.y; }
                if constexpr (F8) { u32x2 w; w.x = pk4_fp8(r[0], r[1], r[2], r[3]); w.y = pk4_fp8(r[4], r[5], r[6], r[7]);
#if ACT_TILED
                    { const int lr = row0 - u.pm * BM + ai * HALF + m * 16;
                      *(u32x2*)((unsigned char*)act + ((size_t)(u.pm * 2 + (lr >> 7)) * 8 + u.pn) * 16384 + (size_t)(lr & 127) * 128 + (col0 - u.pn * HALF)) = w; } }
#elif ACT_SPREAD
                    *(u32x2*)((unsigned char*)act + ((size_t)(row0 - u.pm * BM + ai * HALF + m * 16) * (ACT_ROWS / BM) + u.pm) * DE + col0) = w; }
#else
                    *(u32x2*)((unsigned char*)act + (size_t)(row0 + ai * HALF + m * 16) * DE + col0) = w; }
#endif
                else { u32x4 w; w.x = cvt_pk_bf16(r[0], r[1]); w.y = cvt_pk_bf16(r[2], r[3]); w.z = cvt_pk_bf16(r[4], r[5]); w.w = cvt_pk_bf16(r[6], r[7]);
                    *(u32x4*)((bf16_t*)act + (size_t)(row0 + ai * HALF + m * 16) * DE + col0) = w; } }
    }
};
template <bool F8> struct EpiDown {
    static constexpr bool PERM = true;
    bf16_t* ys; const float* bd; LAS float* lb;
    template <class Sched> __device__ __forceinline__ void preload(const Sched& S, int tid) const {
        float v_[MAXORD]; bool ok_[MAXORD]; const int t = tid - 256;
#pragma unroll
        for (int i = 0; i < MAXORD; ++i) { Unit u; ok_[i] = S.next(i, u); v_[i] = (ok_[i] && tid >= 256) ? bd[u.e * D + u.pn * BM + t] : 0.f; }
#pragma unroll
        for (int i = 0; i < MAXORD; ++i) if (ok_[i] && tid >= 256) lb[i * 256 + t] = v_[i];
    }
    __device__ __forceinline__ void operator()(const f32x4 (&acc)[2][2][4][2], const Unit& u, int wr, int wc, int fr, int fq) const {
        const int nai = u.half ? 1 : 2; const int row0 = u.pm * BM + (u.half == 2 ? HALF : 0) + wr * 64 + fr, col0 = u.pn * BM + wc * 32 + 8 * fq;
        constexpr float sc = F8 ? (1.f / 1024.f) : 1.f;
        f32x4 bv[2][2];
#pragma unroll
        for (int bj = 0; bj < 2; ++bj)
#pragma unroll
            for (int n = 0; n < 2; ++n) { bv[bj][n] = u.ord < MAXORD ? *(const LAS f32x4*)(lb + u.ord * 256 + wc * 32 + 8 * fq + bj * HALF + 4 * n) : *(const f32x4*)(bd + u.e * D + col0 + bj * HALF + 4 * n); if (YS_F8) bv[bj][n] *= 8.f; }
#pragma unroll
        for (int ai = 0; ai < 2; ++ai) if (ai < nai)
#pragma unroll
            for (int m = 0; m < 4; ++m) { bf16_t* rowp = ys + (size_t)(row0 + ai * HALF + m * 16) * D + col0;
#pragma unroll
                for (int bj = 0; bj < 2; ++bj) { constexpr float sc8 = YS_F8 ? 8.f * sc : sc; const f32x4 v0 = acc[ai][bj][m][0] * sc8 + bv[bj][0], v1 = acc[ai][bj][m][1] * sc8 + bv[bj][1];
#if YS_F8
                    u32x2 w; w.x = pk4_fp8(v0[0], v0[1], v0[2], v0[3]); w.y = pk4_fp8(v1[0], v1[1], v1[2], v1[3]);
                    *(u32x2*)((unsigned char*)ys + (size_t)(row0 + ai * HALF + m * 16) * D + col0 + bj * HALF) = w; (void)rowp;
#else
                    u32x4 w; w.x = cvt_pk_bf16(v0[0], v0[1]); w.y = cvt_pk_bf16(v0[2], v0[3]); w.z = cvt_pk_bf16(v1[0], v1[1]); w.w = cvt_pk_bf16(v1[2], v1[3]);
                    *(u32x4*)(rowp + bj * HALF) = w;
#endif
                } }
    }
};

template <class Epi, class Sched, bool ALIGN_EPI, int DT = 0, int PROBE = 0, bool MIDSCALE = false>
__device__ __forceinline__ void gemm_phase(LAS unsigned char* lds, const void* Aptr, const Sched& S, const Epi& E, const int tid) {
    const int wid = __builtin_amdgcn_readfirstlane(tid >> 6), lane = tid & 63, wr = wid >> 2, wc = wid & 3, fr = lane & 15, fq = lane >> 4;
    constexpr bool F8 = DT == 1, I8 = DT == 2; constexpr int KB = DT ? GK : 2 * GK, nt = KB / 128;
    const char* Ab = (const char*)Aptr;
    int sR[2], sC[2]; unsigned voffB[2];
#pragma unroll
    for (int i = 0; i < 2; ++i) { int R, C; if constexpr (DT == 1) stage_rc8(tid * 16 + i * 8192, R, C); else stage_rc(tid * 16 + i * 8192, R, C); sR[i] = R; sC[i] = C; const int Rb = Epi::PERM ? ((R & ~31) + perm32(R & 31)) : R; voffB[i] = (unsigned)(Rb * (Sched::BTILED ? 128 : KB) + 2 * C); }
    constexpr size_t kstep = (size_t)(BK * 2);
#ifndef G8_KROT
#define G8_KROT 0
#endif
    const int krot = (G8_KROT && !MIDSCALE) ? ((int)(blockIdx.x >> 3) & (nt - 1)) : 0;
    const size_t akst = S.akstep();
#define G8_KO(j) ((size_t)(((j) + krot) & (nt - 1)) * akst)
#define G8_KOB(j) ((size_t)(((j) + krot) & (nt - 1)) * (Sched::BTILED ? (size_t)16384 : kstep))
    constexpr size_t hstep = (size_t)HALF * KB;
    const unsigned ldsw = (unsigned)wid * 1024u;
    const int aoff = lds_byte(wr * 64 + fr, fq * 8), boff = lds_byte(wc * 32 + fr, fq * 8);
    const int a8off = lds_byte_b8(wr * 64 + fr, fq * 32), b8off = lds_byte_b8(wc * 32 + fr, fq * 32);
#define G8_SA(b, h) (((b) * 2 + (h)) * HTB)
#define G8_SB(b, h) ((4 + (b) * 2 + (h)) * HTB)
#define G8_STAGE(bufoff, gbase, voff) do { if constexpr (!(PROBE & 8)) _Pragma("unroll") for (int _i = 0; _i < 2; ++_i) \
        __builtin_amdgcn_global_load_lds((const unsigned*)((const char*)(gbase) + (voff)[_i]), (LAS unsigned*)(lds + (bufoff) + ldsw + _i * 8192), 16, 0, 0); } while (0)
#define G8_LDA(dst, dst8, b, h) do { if constexpr ((PROBE & 4) != 0) { _Pragma("unroll") for (int m = 0; m < 4; ++m) asm volatile("" : "+v"(dst8[m])); } else if constexpr (F8) { _Pragma("unroll") for (int m = 0; m < 4; ++m) { const i32x4 lo_ = *(const LAS i32x4*)(lds + G8_SA(b, h) + a8off + m * 2048), hi_ = *(const LAS i32x4*)(lds + G8_SA(b, h) + (a8off ^ 16) + m * 2048); \
            dst8[m] = __builtin_shufflevector(lo_, hi_, 0, 1, 2, 3, 4, 5, 6, 7); } } \
        else { _Pragma("unroll") for (int m = 0; m < 4; ++m) _Pragma("unroll") for (int k = 0; k < 2; ++k) dst[m][k] = *(const LAS bf16x8*)(lds + G8_SA(b, h) + aoff + m * 2048 + k * 1024); } } while (0)
#define G8_LDB(dst, dst8, b, h) do { if constexpr ((PROBE & 4) != 0) { _Pragma("unroll") for (int n = 0; n < 2; ++n) asm volatile("" : "+v"(dst8[n])); } else if constexpr (F8) { _Pragma("unroll") for (int n = 0; n < 2; ++n) { const i32x4 lo_ = *(const LAS i32x4*)(lds + G8_SB(b, h) + b8off + n * 2048), hi_ = *(const LAS i32x4*)(lds + G8_SB(b, h) + (b8off ^ 16) + n * 2048); \
            dst8[n] = __builtin_shufflevector(lo_, hi_, 0, 1, 2, 3, 4, 5, 6, 7); } } \
        else { _Pragma("unroll") for (int n = 0; n < 2; ++n) _Pragma("unroll") for (int k = 0; k < 2; ++k) dst[n][k] = *(const LAS bf16x8*)(lds + G8_SB(b, h) + boff + n * 2048 + k * 1024); } } while (0)
#define G8_MMA(ai, bj, At, At8, Bt, Bt8) do { __builtin_amdgcn_s_setprio(1); if constexpr (PROBE & 1) { _Pragma("unroll") for (int m = 0; m < 4; ++m) asm volatile("" :: "v"(At8[m]), "v"(Bt8[m & 1])); } else if constexpr (F8) { _Pragma("unroll") for (int m = 0; m < 4; ++m) _Pragma("unroll") for (int n = 0; n < 2; ++n) \
            asm volatile("v_mfma_f32_16x16x128_f8f6f4 %0, %1, %2, %0" : "+v"(acc[ai][bj][m][n]) : "v"(Bt8[n]), "v"(At8[m])); } \
        else if constexpr (I8) { _Pragma("unroll") for (int m = 0; m < 4; ++m) _Pragma("unroll") for (int n = 0; n < 2; ++n) _Pragma("unroll") for (int k = 0; k < 2; ++k) \
            acc[ai][bj][m][n] = __builtin_bit_cast(f32x4, __builtin_amdgcn_mfma_i32_16x16x64_i8(__builtin_bit_cast(i32x4, Bt[n][k]), __builtin_bit_cast(i32x4, At[m][k]), __builtin_bit_cast(i32x4, acc[ai][bj][m][n]), 0, 0, 0)); } \
        else { _Pragma("unroll") for (int m = 0; m < 4; ++m) _Pragma("unroll") for (int n = 0; n < 2; ++n) _Pragma("unroll") for (int k = 0; k < 2; ++k) \
            acc[ai][bj][m][n] = __builtin_amdgcn_mfma_f32_16x16x32_bf16(Bt[n][k], At[m][k], acc[ai][bj][m][n], 0, 0, 0); } __builtin_amdgcn_s_setprio(0); } while (0)
#define G8_MMAZ(ai, bj, At, At8, Bt, Bt8) do { __builtin_amdgcn_s_setprio(1); if constexpr (PROBE & 1) { _Pragma("unroll") for (int m = 0; m < 4; ++m) asm volatile("" :: "v"(At8[m]), "v"(Bt8[m & 1])); } else if constexpr (F8) { _Pragma("unroll") for (int m = 0; m < 4; ++m) _Pragma("unroll") for (int n = 0; n < 2; ++n) \
            asm volatile("v_mfma_f32_16x16x128_f8f6f4 %0, %1, %2, 0" : "=&v"(acc[ai][bj][m][n]) : "v"(Bt8[n]), "v"(At8[m])); } \
        else if constexpr (I8) { _Pragma("unroll") for (int m = 0; m < 4; ++m) _Pragma("unroll") for (int n = 0; n < 2; ++n) { i32x4 c_ = __builtin_amdgcn_mfma_i32_16x16x64_i8(__builtin_bit_cast(i32x4, Bt[n][0]), __builtin_bit_cast(i32x4, At[m][0]), (i32x4){0, 0, 0, 0}, 0, 0, 0); \
            acc[ai][bj][m][n] = __builtin_bit_cast(f32x4, __builtin_amdgcn_mfma_i32_16x16x64_i8(__builtin_bit_cast(i32x4, Bt[n][1]), __builtin_bit_cast(i32x4, At[m][1]), c_, 0, 0, 0)); } } \
        else { _Pragma("unroll") for (int m = 0; m < 4; ++m) _Pragma("unroll") for (int n = 0; n < 2; ++n) { const f32x4 c_ = __builtin_amdgcn_mfma_f32_16x16x32_bf16(Bt[n][0], At[m][0], (f32x4){0.f, 0.f, 0.f, 0.f}, 0, 0, 0); \
            acc[ai][bj][m][n] = __builtin_amdgcn_mfma_f32_16x16x32_bf16(Bt[n][1], At[m][1], c_, 0, 0, 0); } } __builtin_amdgcn_s_setprio(0); } while (0)
#define G8_MMAF(ai, bj, At, At8, Bt, Bt8) do { if (t == 0) G8_MMAZ(ai, bj, At, At8, Bt, Bt8); else G8_MMA(ai, bj, At, At8, Bt, Bt8); } while (0)
#define G8_WAIT_V(n) asm volatile("s_waitcnt vmcnt(" #n ")" ::: "memory")
#define G8_WAIT_L(n) asm volatile("s_waitcnt lgkmcnt(" #n ")" ::: "memory")
#define G8_BAR __builtin_amdgcn_s_barrier()
#ifndef G8_PINGPONG
#define G8_PINGPONG 1
#endif
#define G8_BAR2 do { if (G8_PINGPONG) G8_BAR; } while (0)
#define G8_SCHED __builtin_amdgcn_sched_barrier(0)
#define G8_ROWS(dst, u) do { _Pragma("unroll") for (int _h = 0; _h < 2; ++_h) _Pragma("unroll") for (int _i = 0; _i < 2; ++_i) dst[_h][_i] = S.aoff(u, _h * HALF + sR[_i], KB) + 2u * (unsigned)sC[_i]; } while (0)
    S.preload(lds, tid); E.preload(S, tid);
    __syncthreads();
    Unit cur, nxt; int ui = 0;
    if (!S.next(0, cur)) return;
    f32x4 acc[2][2][4][2];
#pragma unroll
    for (int a = 0; a < 2; ++a)
#pragma unroll
        for (int b = 0; b < 2; ++b)
#pragma unroll
            for (int m = 0; m < 4; ++m)
#pragma unroll
                for (int n = 0; n < 2; ++n) acc[a][b][m][n] = (f32x4){0.f, 0.f, 0.f, 0.f};
    bf16x8 At[4][2], B0[2][2], B1[2][2]; v8i At8[4], B08[2], B18[2];
    unsigned arc[2][2], arn[2][2];
    G8_ROWS(arc, cur);
    const char* cB = S.bbase(cur);
    G8_STAGE(G8_SB(0, 0), cB + G8_KOB(0), voffB); G8_STAGE(G8_SB(0, 1), cB + hstep + G8_KOB(0), voffB); G8_STAGE(G8_SA(0, 0), Ab + G8_KO(0), arc[0]); G8_STAGE(G8_SA(0, 1), Ab + G8_KO(0), arc[1]);
    if (G8_PINGPONG && wr == 1) G8_BAR;
    G8_WAIT_V(2); G8_BAR;
    G8_STAGE(G8_SB(1, 0), cB + G8_KOB(1), voffB); G8_STAGE(G8_SA(1, 0), Ab + G8_KO(1), arc[0]); G8_STAGE(G8_SB(1, 1), cB + hstep + G8_KOB(1), voffB);
    G8_WAIT_V(6); G8_BAR;
    for (;;) {
        const bool has_next = S.next(ui + 1, nxt);
        const char* nB = cB;
        if (has_next) { G8_ROWS(arn, nxt); nB = S.bbase(nxt); }
        else {
#pragma unroll
            for (int h = 0; h < 2; ++h)
#pragma unroll
                for (int i = 0; i < 2; ++i) arn[h][i] = arc[h][i];
        }
#pragma unroll 1
        for (int t = 0; t < nt; t += 2) {
            const bool last = (t == nt - 2);
            if constexpr (MIDSCALE) { if (t == nt / 2) {
#pragma unroll
                for (int ai = 0; ai < 2; ++ai)
#pragma unroll
                    for (int m = 0; m < 4; ++m) { const float rs_ = E.rowscale(cur, ai * HALF + wr * 64 + m * 16 + fr);
#pragma unroll
                        for (int bj = 0; bj < 2; ++bj)
#pragma unroll
                            for (int n = 0; n < 2; ++n) acc[ai][bj][m][n] *= rs_; } } }
            const int j2 = last ? 0 : t + 2;
            const char* a1 = Ab + G8_KO(t + 1);
            const char* a2 = Ab + G8_KO(j2); const char* b2 = (last ? nB : cB) + G8_KOB(j2);
            const char* a3 = Ab + G8_KO(j2 + 1); const char* b3 = (last ? nB : cB) + G8_KOB(j2 + 1);
            unsigned ar2[2][2];
#pragma unroll
            for (int h = 0; h < 2; ++h)
#pragma unroll
                for (int i = 0; i < 2; ++i) ar2[h][i] = last ? arn[h][i] : arc[h][i];
            G8_LDB(B0, B08, 0, 0); G8_LDB(B1, B18, 0, 1); G8_SCHED; G8_LDA(At, At8, 0, 0); G8_STAGE(G8_SA(1, 1), a1, arc[1]);
            G8_WAIT_V(8); G8_WAIT_L(0); G8_BAR; G8_MMA(0, 0, At, At8, B0, B08); G8_MMA(0, 1, At, At8, B1, B18); G8_BAR2; G8_SCHED;
            G8_LDA(At, At8, 0, 1); G8_STAGE(G8_SB(0, 0), b2, voffB); G8_STAGE(G8_SB(0, 1), b2 + hstep, voffB); G8_STAGE(G8_SA(0, 0), a2, ar2[0]);
            G8_WAIT_V(8); G8_WAIT_L(0); G8_BAR; if (!cur.half) { G8_MMA(1, 0, At, At8, B0, B08); G8_MMA(1, 1, At, At8, B1, B18); } G8_BAR2; G8_SCHED;
            G8_LDB(B0, B08, 1, 0); G8_LDB(B1, B18, 1, 1); G8_SCHED; G8_LDA(At, At8, 1, 0); G8_STAGE(G8_SA(0, 1), a2, ar2[1]);
            G8_WAIT_V(8); G8_WAIT_L(0); G8_BAR; G8_MMA(0, 0, At, At8, B0, B08); G8_MMA(0, 1, At, At8, B1, B18); G8_BAR2; G8_SCHED;
            G8_LDA(At, At8, 1, 1); G8_STAGE(G8_SB(1, 0), b3, voffB); G8_STAGE(G8_SB(1, 1), b3 + hstep, voffB); G8_STAGE(G8_SA(1, 0), a3, ar2[0]);
            G8_WAIT_V(8); G8_WAIT_L(0); G8_BAR; if (!cur.half) { G8_MMA(1, 0, At, At8, B0, B08); G8_MMA(1, 1, At, At8, B1, B18); } G8_BAR2; G8_SCHED;
        }
        if constexpr (ALIGN_EPI && G8_PINGPONG) { if (wr == 0) G8_BAR; }
        if constexpr (F8) asm volatile("s_nop 15\n\ts_nop 15" ::: "memory");
        if constexpr (!(PROBE & 2)) E(acc, cur, wr, wc, fr, fq); else { _Pragma("unroll") for (int m = 0; m < 4; ++m) asm volatile("" :: "v"(acc[0][0][m][0]), "v"(acc[1][1][m][1])); }
        if (!has_next) break;
#pragma unroll
        for (int a = 0; a < 2; ++a)
#pragma unroll
            for (int b = 0; b < 2; ++b)
#pragma unroll
                for (int m = 0; m < 4; ++m)
#pragma unroll
                    for (int n = 0; n < 2; ++n) acc[a][b][m][n] = (f32x4){0.f, 0.f, 0.f, 0.f};
        cur = nxt; cB = nB; ++ui;
#pragma unroll
        for (int h = 0; h < 2; ++h)
#pragma unroll
            for (int i = 0; i < 2; ++i) arc[h][i] = arn[h][i];
        if constexpr (ALIGN_EPI && G8_PINGPONG) { if (wr == 1) G8_BAR; }
    }
    G8_WAIT_V(0);
    if constexpr (!ALIGN_EPI && G8_PINGPONG) { if (wr == 0) G8_BAR; }
    G8_BAR;
#undef G8_SA
#undef G8_SB
#undef G8_STAGE
#undef G8_LDA
#undef G8_LDB
#undef G8_MMA
#undef G8_MMAZ
#undef G8_MMAF
#undef G8_WAIT_V
#undef G8_WAIT_L
#undef G8_BAR
#undef G8_BAR2
#undef G8_KO
#undef G8_KOB
#undef G8_SCHED
#undef G8_ROWS
}
}
namespace attn_body {
using bf16=unsigned short;

using s16x4=__attribute__((ext_vector_type(4)))short;
using f32x16=__attribute__((ext_vector_type(16)))float;

constexpr int BATCH=2,NHEAD=8,SEQ=8192,D=64,QP=2560,KP=2560,VP=2560,OP=1024;
constexpr int NW=8,QBLK=32,QB=QBLK*NW,KVBLK=64,NQB=SEQ/QB;
constexpr int ATTN_UNIT_ROWS=QB;
__device__ __forceinline__ int crow(int r,int hi){return (r&3)+8*(r>>2)+4*hi;}
#define SBAR() __builtin_amdgcn_sched_barrier(0)
__device__ __forceinline__ void cmask(f32x16&p0,f32x16&p1,int jb,int qrel,int hi){
  const float NEG=-INFINITY; int kb=64*jb+4*hi;
  #pragma unroll
  for(int r=0;r<16;++r){int kv=kb+(r&3)+8*(r>>2); if(kv>qrel)p0[r]=NEG; if(kv+32>qrel)p1[r]=NEG;}
}

constexpr int NSLOT=3, SLOTB=8192;
constexpr int LDS_K=0, LDS_V=NSLOT*SLOTB, LDS_WS=2*NSLOT*SLOTB, LDS_OST=LDS_WS+NW*64*4, LDS_BYTES=LDS_OST+NW*4096;
__device__ __forceinline__ void glds16(const void*gsrc,unsigned lds_dst){unsigned keep;
  asm volatile("s_mov_b32 %0, m0\n\ts_mov_b32 m0, %2\n\ts_nop 0\n\tglobal_load_lds_dwordx4 %1, off\n\ts_mov_b32 m0, %0":"=&s"(keep):"v"(gsrc),"s"(lds_dst):"memory");}
__device__ __forceinline__ float max3f(float a,float b,float c){float r;asm("v_max3_f32 %0, %1, %2, %3":"=v"(r):"v"(a),"v"(b),"v"(c));return r;}
__device__ __forceinline__ float max2f(float a,float b){float r;asm("v_max_f32_e32 %0, %1, %2":"=v"(r):"v"(a),"v"(b));return r;}
__device__ __forceinline__ float fadd_s(float a,float b){float r;asm("v_add_f32_e32 %0, %1, %2":"=v"(r):"v"(a),"v"(b));return r;}
__device__ __forceinline__ float fsub_s(float a,float b){float r;asm("v_sub_f32_e32 %0, %1, %2":"=v"(r):"v"(a),"v"(b));return r;}
typedef float f32x2_t __attribute__((ext_vector_type(2))); typedef __bf16 bf16x2_t __attribute__((ext_vector_type(2)));
__device__ __forceinline__ unsigned cvtpk_s(float lo,float hi){f32x2_t v={lo,hi};bf16x2_t b=__builtin_convertvector(v,bf16x2_t);return __builtin_bit_cast(unsigned,b);}
#define WAIT_BAR(N) asm volatile("s_waitcnt vmcnt(" #N ") lgkmcnt(0)\n\ts_barrier":::"memory")

__device__ __forceinline__ void qkt(f32x16&p0,f32x16&p1,const char*Kslot,const bf16x8*qr,const f32x16&negm,int r32,int hi){
  const char*kb=Kslot+hi*1024+r32*16;
  #pragma unroll
  for(int d0=0;d0<4;++d0){
    const bf16x8 b0=*reinterpret_cast<const bf16x8*>(kb+d0*2048);
    const bf16x8 b1=*reinterpret_cast<const bf16x8*>(kb+d0*2048+512);
    if(d0==0){p0=__builtin_amdgcn_mfma_f32_32x32x16_bf16(b0,qr[0],negm,0,0,0);p1=__builtin_amdgcn_mfma_f32_32x32x16_bf16(b1,qr[0],negm,0,0,0);}
    else{p0=__builtin_amdgcn_mfma_f32_32x32x16_bf16(b0,qr[d0],p0,0,0,0);p1=__builtin_amdgcn_mfma_f32_32x32x16_bf16(b1,qr[d0],p1,0,0,0);}}
}
typedef __attribute__((address_space(3))) const char* lds_cptr;
typedef short v4i16_t __attribute__((ext_vector_type(4)));
__device__ __forceinline__ void kload8(bf16x8*kf,lds_cptr kp){
  kf[0]=*(const __attribute__((address_space(3))) bf16x8*)(kp);      kf[1]=*(const __attribute__((address_space(3))) bf16x8*)(kp+512);
  kf[2]=*(const __attribute__((address_space(3))) bf16x8*)(kp+2048); kf[3]=*(const __attribute__((address_space(3))) bf16x8*)(kp+2560);
  kf[4]=*(const __attribute__((address_space(3))) bf16x8*)(kp+4096); kf[5]=*(const __attribute__((address_space(3))) bf16x8*)(kp+4608);
  kf[6]=*(const __attribute__((address_space(3))) bf16x8*)(kp+6144); kf[7]=*(const __attribute__((address_space(3))) bf16x8*)(kp+6656);
}
__device__ __forceinline__ void kload2(bf16x8*kf,lds_cptr kp,int j){ kf[2*j]=*(const __attribute__((address_space(3))) bf16x8*)(kp+j*2048); kf[2*j+1]=*(const __attribute__((address_space(3))) bf16x8*)(kp+j*2048+512); }
__device__ __forceinline__ s16x4 vtr(lds_cptr p){ return __builtin_bit_cast(s16x4,__builtin_amdgcn_ds_read_tr16_b64_v4i16((__attribute__((address_space(3))) v4i16_t*)p)); }
__device__ __forceinline__ float rowmax(const f32x16&p0,const f32x16&p1){
  float a=max3f(p0[0],p0[1],p1[0]),b=max3f(p0[2],p0[3],p1[1]);a=max3f(a,p1[2],p1[3]);
  #pragma unroll
  for(int r=4;r<16;r+=4){a=max3f(a,p0[r],p0[r+1]);b=max3f(b,p0[r+2],p0[r+3]);a=max3f(a,p1[r],p1[r+1]);b=max3f(b,p1[r+2],p1[r+3]);}
  const float m=max2f(a,b);
  auto rr=__builtin_amdgcn_permlane32_swap(__float_as_uint(m),__float_as_uint(m),false,false);
  return max2f(__uint_as_float(rr[0]),__uint_as_float(rr[1]));
}
__device__ __forceinline__ void pv(f32x16*o,int vb,bf16x8 pa0,bf16x8 pa1,bf16x8 pa2,bf16x8 pa3){
  #pragma unroll
  for(int d0=0;d0<2;++d0){s16x4 lo[4],hi[4];
    #pragma unroll
    for(int ks=0;ks<4;++ks){
      asm volatile("ds_read_b64_tr_b16 %0,%1 offset:%c2":"=&v"(lo[ks]):"v"(vb),"i"(d0*4096+ks*1024):"memory");
      asm volatile("ds_read_b64_tr_b16 %0,%1 offset:%c2":"=&v"(hi[ks]):"v"(vb),"i"(d0*4096+ks*1024+512):"memory");}
    asm volatile("s_waitcnt lgkmcnt(0)":::"memory");SBAR();
    #define PK(k) (bf16x8){lo[k][0],lo[k][1],lo[k][2],lo[k][3],hi[k][0],hi[k][1],hi[k][2],hi[k][3]}
    o[d0]=__builtin_amdgcn_mfma_f32_32x32x16_bf16(pa0,PK(0),o[d0],0,0,0);
    o[d0]=__builtin_amdgcn_mfma_f32_32x32x16_bf16(pa1,PK(1),o[d0],0,0,0);
    o[d0]=__builtin_amdgcn_mfma_f32_32x32x16_bf16(pa2,PK(2),o[d0],0,0,0);
    o[d0]=__builtin_amdgcn_mfma_f32_32x32x16_bf16(pa3,PK(3),o[d0],0,0,0);
    #undef PK
  }
}

#ifndef ATTN_STORE16
#define ATTN_STORE16(p,v) (*(u32x4*)(p)=(v))
#endif
template<int THRL,bool FIXM,int ABL=0> __device__ __forceinline__ void attn_unit(int b,int h,int qb,const bf16*Q,const bf16*K,const bf16*V,bf16*O,float*SSQ,char*shm,const int tid,const float mfix){
  const int lane=tid&63,r32=lane&31,hi=lane>>5; const int wid=__builtin_amdgcn_readfirstlane(tid>>6);
  const long rowbase=(long)b*SEQ; const int q0=qb*QB;
  const bf16*Qw=Q+(rowbase+q0+wid*QBLK)*QP+h*D;
  const bf16*Kh=K+rowbase*KP+(h>>2)*D,*Vh=V+rowbase*VP+(h>>2)*D;
  const unsigned lds0=(unsigned)(uintptr_t)shm;
  float*wsf=(float*)(shm+LDS_WS)+wid*64;
  const bf16*ksrc=Kh+(long)lane*KP+wid*8;
  const bf16*vsrc=Vh+(long)(16*(wid&3)+(lane>>2))*VP+(wid>>2)*32+(lane&3)*8;
  const unsigned kdst=lds0+LDS_K+wid*1024, vdst=lds0+LDS_V+wid*1024;
  #define DMA_K(t,slot) glds16(ksrc+(long)(t)*KVBLK*KP,(unsigned)__builtin_amdgcn_readfirstlane(kdst+(slot)))
  #define DMA_V(t,slot) glds16(vsrc+(long)(t)*KVBLK*VP,(unsigned)__builtin_amdgcn_readfirstlane(vdst+(slot)))
  const int vb0=(int)(lds0+LDS_V)+((lane>>4)&1)*32+(lane&3)*8+(4*hi+((lane&15)>>2))*64;
  const char*Kbase=shm+LDS_K; bf16x8 kf[8];
  const lds_cptr shm3=(lds_cptr)shm; const lds_cptr kp0=shm3+LDS_K+hi*1024+r32*16; const lds_cptr vp0=shm3+LDS_V+((lane>>4)&1)*32+(lane&3)*8+(4*hi+((lane&15)>>2))*64;
  constexpr int NT=SEQ/KVBLK;
  DMA_K(0,0);DMA_V(0,0);DMA_K(1,SLOTB);
  bf16x8 qr[4];
  #pragma unroll
  for(int d0=0;d0<4;++d0)qr[d0]=*reinterpret_cast<const bf16x8*>(&Qw[(long)r32*QP+d0*16+hi*8]);
  float mhat=0.f,l_reg=0.f;f32x16 o[2];o[0]=f32x16{};o[1]=f32x16{};f32x16 negm=f32x16{};
  if constexpr(!FIXM) asm volatile("":"+v"(negm));
  const int qrel=wid*QBLK+r32;(void)qrel;
  #define CMASK(P0,P1,t) do{}while(0)
  bool resc=false;
  #define START(P0,P1) do{ if constexpr(!FIXM){ const float rm=rowmax(P0,P1); resc=false; \
    { const float dl=rm; mhat=fadd_s(mhat,dl); \
      _Pragma("unroll") for(int r=0;r<16;++r){P0[r]=fsub_s(P0[r],dl);P1[r]=fsub_s(P1[r],dl);} \
      _Pragma("unroll") for(int r=0;r<16;++r)negm[r]=-mhat; asm volatile("":"+v"(negm)); } } \
    _Pragma("unroll") for(int r=0;r<16;++r)P0[r]=__builtin_amdgcn_exp2f(P0[r]); }while(0)
  #define RESC() do{ if constexpr(!FIXM) if(resc){ asm volatile("s_waitcnt lgkmcnt(0)":::"memory"); \
      _Pragma("unroll") for(int d_=0;d_<2;++d_) _Pragma("unroll") for(int r=0;r<16;++r)o[d_][r]*=wsf[crow(r,hi)]; } }while(0)
  f32x16 pA0,pA1,pB0,pB1;
  int sl_prev=0,sl_cur=0,sl_next=SLOTB;
  #define ROT() do{sl_prev=sl_cur;sl_cur=sl_next;sl_next=(sl_next==(NSLOT-1)*SLOTB)?0:sl_next+SLOTB;}while(0)
  DMA_K(2,2*SLOTB);
  WAIT_BAR(3);
  qkt(pA0,pA1,Kbase,qr,negm,r32,hi);asm volatile("s_nop 15\n\ts_nop 7":"+v"(pA0),"+v"(pA1));CMASK(pA0,pA1,0);
  START(pA0,pA1);
  _Pragma("unroll") for(int r=0;r<16;++r)pA1[r]=__builtin_amdgcn_exp2f(pA1[r]);
  WAIT_BAR(0);
  DMA_K(3,0);DMA_V(1,SLOTB);
  ROT();
  kload8(kf,kp0+sl_cur);
  WAIT_BAR(2);
  s16x4 vlo[8],vhi[8]; u32x4 pw0,pw1,pw2,pw3;
  #define PKW(P,B) cvtpk_s(P[B],P[B+1])
  #define PAF(k) __builtin_bit_cast(bf16x8,pw##k)
  #define VFR(i) (bf16x8){vlo[i][0],vlo[i][1],vlo[i][2],vlo[i][3],vhi[i][0],vhi[i][1],vhi[i][2],vhi[i][3]}
  #define PIN(x) asm volatile("":"+v"(x))
  #define MX3(a,b,c) __builtin_fmaxf(__builtin_fmaxf((a),(b)),(c))
  #define GAPA(MF,A0,A1,A2,A3,W0,W1,PW) do{ MF; if constexpr(ABL!=2){ sacc+=A0; sacc+=A1; sacc+=A2; sacc+=A3; } PIN(sacc); W0; W1; PIN(PW); SBAR(); }while(0)
  #define EX(v) (ABL==1?(v)*1.0009765625f:__builtin_amdgcn_exp2f(v))
  #define GAPB(MF,X,B) do{ MF; X[B]=EX(X[B]); X[B+1]=EX(X[B+1]); X[B+2]=EX(X[B+2]); X[B+3]=EX(X[B+3]); PIN(X); SBAR(); }while(0)
  #define PVM(X,PA,VF) do{ if constexpr(ABL!=3){X;} else { asm volatile(""::"v"(PA),"v"(VF)); } }while(0)
  #define VRD(i) do{ vlo[i]=vtr(vp_+(((i)>>2)*4096+((i)&3)*1024)); vhi[i]=vtr(vp_+(((i)>>2)*4096+((i)&3)*1024+512)); }while(0)
  #define KRD(G,j) do{ if(G){ kload2(kf,kp0+sl_next,j); SBAR(); } }while(0)
  #define STEP(C0,C1,P0,P1,t,GK,GV,GL) do{ SBAR(); \
    const lds_cptr vp_=vp0+sl_prev; \
    VRD(0); SBAR(); float sacc=(P0[0]+P0[1]); \
    GAPA(C0=__builtin_amdgcn_mfma_f32_32x32x16_bf16(kf[0],qr[0],negm,0,0,0), P0[2],P0[3],P0[4],P0[5],     pw0[0]=PKW(P0,0), pw0[1]=PKW(P0,2), pw0); \
    VRD(4); SBAR(); GAPA(C1=__builtin_amdgcn_mfma_f32_32x32x16_bf16(kf[1],qr[0],negm,0,0,0), P0[6],P0[7],P0[8],P0[9],     pw0[2]=PKW(P0,4), pw0[3]=PKW(P0,6), pw0); \
    VRD(1); SBAR(); GAPA(C0=__builtin_amdgcn_mfma_f32_32x32x16_bf16(kf[2],qr[1],C0,0,0,0),   P0[10],P0[11],P0[12],P0[13], pw1[0]=PKW(P0,8), pw1[1]=PKW(P0,10), pw1); \
    VRD(5); SBAR(); GAPA(C1=__builtin_amdgcn_mfma_f32_32x32x16_bf16(kf[3],qr[1],C1,0,0,0),   P0[14],P0[15],P1[0],P1[1],   pw1[2]=PKW(P0,12),pw1[3]=PKW(P0,14), pw1); \
    VRD(2); SBAR(); GAPA(C0=__builtin_amdgcn_mfma_f32_32x32x16_bf16(kf[4],qr[2],C0,0,0,0),   P1[2],P1[3],P1[4],P1[5],     pw2[0]=PKW(P1,0), pw2[1]=PKW(P1,2), pw2); \
    VRD(6); SBAR(); GAPA(C1=__builtin_amdgcn_mfma_f32_32x32x16_bf16(kf[5],qr[2],C1,0,0,0),   P1[6],P1[7],P1[8],P1[9],     pw2[2]=PKW(P1,4), pw2[3]=PKW(P1,6), pw2); \
    VRD(3); SBAR(); GAPA(C0=__builtin_amdgcn_mfma_f32_32x32x16_bf16(kf[6],qr[3],C0,0,0,0),   P1[10],P1[11],P1[12],P1[13], pw3[0]=PKW(P1,8), pw3[1]=PKW(P1,10), pw3); \
    VRD(7); SBAR(); GAPA(C1=__builtin_amdgcn_mfma_f32_32x32x16_bf16(kf[7],qr[3],C1,0,0,0),   P1[14],P1[15],0.f,0.f,       pw3[2]=PKW(P1,12),pw3[3]=PKW(P1,14), pw3); \
    l_reg+=sacc; \
    if constexpr(ABL!=4){ if(GK){DMA_K((t)+3,sl_cur);} if(GV){DMA_V((t)+1,sl_next);} } \
    CMASK(C0,C1,t); \
    if constexpr(!FIXM){ float a=MX3(C0[0],C0[1],C1[0]),b=MX3(C0[2],C0[3],C1[1]); a=MX3(a,C1[2],C1[3]); \
      _Pragma("unroll") for(int r=4;r<16;r+=4){a=MX3(a,C0[r],C0[r+1]);b=MX3(b,C0[r+2],C0[r+3]);a=MX3(a,C1[r],C1[r+1]);b=MX3(b,C1[r+2],C1[r+3]);} \
      float rm=__builtin_fmaxf(a,b); { auto rr=__builtin_amdgcn_permlane32_swap(__float_as_uint(rm),__float_as_uint(rm),false,false); rm=__builtin_fmaxf(__uint_as_float(rr[0]),__uint_as_float(rr[1])); } \
      resc=false; \
      if(__builtin_expect(__any(rm>(float)THRL),0)){ const float dl=__builtin_fmaxf(rm,0.f); mhat+=dl; \
        _Pragma("unroll") for(int r=0;r<16;++r){C0[r]-=dl;C1[r]-=dl;} \
        _Pragma("unroll") for(int r=0;r<16;++r)negm[r]=-mhat; asm volatile("":"+v"(negm)); \
        const float f=__builtin_amdgcn_exp2f(-dl); l_reg*=f; if(hi==0)wsf[r32]=f; resc=true; } } \
    SBAR(); \
    GAPB(PVM(o[0]=__builtin_amdgcn_mfma_f32_32x32x16_bf16(PAF(0),VFR(0),o[0],0,0,0),PAF(0),VFR(0)), C0,0); \
    GAPB(PVM(o[1]=__builtin_amdgcn_mfma_f32_32x32x16_bf16(PAF(0),VFR(4),o[1],0,0,0),PAF(0),VFR(4)), C0,4); \
    KRD(GL,0); GAPB(PVM(o[0]=__builtin_amdgcn_mfma_f32_32x32x16_bf16(PAF(1),VFR(1),o[0],0,0,0),PAF(1),VFR(1)), C0,8); \
    KRD(GL,1); GAPB(PVM(o[1]=__builtin_amdgcn_mfma_f32_32x32x16_bf16(PAF(1),VFR(5),o[1],0,0,0),PAF(1),VFR(5)), C0,12); \
    KRD(GL,2); GAPB(PVM(o[0]=__builtin_amdgcn_mfma_f32_32x32x16_bf16(PAF(2),VFR(2),o[0],0,0,0),PAF(2),VFR(2)), C1,0); \
    KRD(GL,3); GAPB(PVM(o[1]=__builtin_amdgcn_mfma_f32_32x32x16_bf16(PAF(2),VFR(6),o[1],0,0,0),PAF(2),VFR(6)), C1,4); \
    GAPB(PVM(o[0]=__builtin_amdgcn_mfma_f32_32x32x16_bf16(PAF(3),VFR(3),o[0],0,0,0),PAF(3),VFR(3)), C1,8); \
    GAPB(PVM(o[1]=__builtin_amdgcn_mfma_f32_32x32x16_bf16(PAF(3),VFR(7),o[1],0,0,0),PAF(3),VFR(7)), C1,12); \
    }while(0)
  int t=1;
  #undef CMASK
  #define CMASK(P0,P1,t) do{}while(0)
  for(;t+5<NT;t+=2){
    STEP(pB0,pB1,pA0,pA1,t,true,true,true);     if constexpr(ABL==5){ asm volatile("s_waitcnt vmcnt(2) lgkmcnt(0)":::"memory"); } else if constexpr(ABL==4){ asm volatile("s_waitcnt lgkmcnt(0)\n\ts_barrier":::"memory"); } else { WAIT_BAR(2); } RESC(); ROT();
    STEP(pA0,pA1,pB0,pB1,t+1,true,true,true);   if constexpr(ABL==5){ asm volatile("s_waitcnt vmcnt(2) lgkmcnt(0)":::"memory"); } else if constexpr(ABL==4){ asm volatile("s_waitcnt lgkmcnt(0)\n\ts_barrier":::"memory"); } else { WAIT_BAR(2); } RESC(); ROT();
  }
  #undef CMASK
  #define CMASK(P0,P1,t) do{}while(0)
  #define ENDW(tt) do{ if((tt)+3<NT){WAIT_BAR(2);} else if((tt)+2<NT){WAIT_BAR(1);} else {WAIT_BAR(0);} }while(0)
  for(;t+1<NT;t+=2){
    STEP(pB0,pB1,pA0,pA1,t,(t+3<NT),(t+1<NT),(t+1<NT));       ENDW(t);   RESC(); ROT();
    STEP(pA0,pA1,pB0,pB1,t+1,(t+4<NT),(t+2<NT),(t+2<NT));     ENDW(t+1); RESC(); ROT();
  }
  STEP(pB0,pB1,pA0,pA1,NT-1,false,false,false); RESC();
  { float sacc=pB0[0]+pB0[1]; _Pragma("unroll") for(int r=2;r<16;++r)sacc+=pB0[r]; _Pragma("unroll") for(int r=0;r<16;++r)sacc+=pB1[r]; l_reg+=sacc;
    pw0=(u32x4){PKW(pB0,0),PKW(pB0,2),PKW(pB0,4),PKW(pB0,6)};pw1=(u32x4){PKW(pB0,8),PKW(pB0,10),PKW(pB0,12),PKW(pB0,14)};pw2=(u32x4){PKW(pB1,0),PKW(pB1,2),PKW(pB1,4),PKW(pB1,6)};pw3=(u32x4){PKW(pB1,8),PKW(pB1,10),PKW(pB1,12),PKW(pB1,14)};
    SBAR(); pv(o,vb0+sl_cur,PAF(0),PAF(1),PAF(2),PAF(3)); }
  #undef PKW
  #undef PAF
  #undef VFR
  #undef PIN
  #undef MX3
  #undef GAPA
  #undef GAPB
  #undef EX
  #undef VRD
  #undef PVM
  #undef KRD
  #undef STEP
  #undef ENDW
  {auto rr=__builtin_amdgcn_permlane32_swap(__float_as_uint(l_reg),__float_as_uint(l_reg),false,false);l_reg=__uint_as_float(rr[0])+__uint_as_float(rr[1]);}
  if(hi==0)wsf[32+r32]=l_reg;asm volatile("s_waitcnt lgkmcnt(0)":::"memory");
  float rli[16];
  #pragma unroll
  for(int r=0;r<16;++r)rli[r]=__builtin_amdgcn_rcpf(wsf[32+crow(r,hi)]);
  bf16*Ow=O+(rowbase+q0+wid*QBLK)*OP+h*D;
  { bf16*stg=(bf16*)(shm+LDS_OST)+wid*2048;
    #pragma unroll
    for(int r=0;r<16;++r){const int orow=crow(r,hi);
      #pragma unroll
      for(int d0=0;d0<2;++d0)stg[orow*64+d0*32+r32]=(bf16)f2bf(o[d0][r]*rli[r]);}
    asm volatile("s_waitcnt lgkmcnt(0)":::"memory");
    #pragma unroll
    for(int i=0;i<4;++i){const int row=i*8+(lane>>3),ch=lane&7; const u32x4 v=*(const u32x4*)(stg+row*64+ch*8); ATTN_STORE16(Ow+(long)row*OP+ch*8,v);
      if(SSQ){ const unsigned w_[4]={v.x,v.y,v.z,v.w}; float s_=0.f;
        #pragma unroll
        for(int k=0;k<4;++k){const float a_=__uint_as_float(w_[k]<<16),b_=__uint_as_float(w_[k]&0xffff0000u);s_+=a_*a_+b_*b_;}
        s_+=__shfl_xor(s_,1);s_+=__shfl_xor(s_,2);s_+=__shfl_xor(s_,4);
        if(ch==0)SSQ[(rowbase+q0+wid*QBLK+row)*NHEAD+h]=s_; } } }
  asm volatile("s_waitcnt lgkmcnt(0)\n\ts_barrier":::"memory");
  #undef DMA_K
  #undef DMA_V
  #undef CMASK
  #undef START
  #undef RESC
  #undef ROT
}

namespace fx { constexpr int NSK=4, NSV=3, LDS_K=0, LDS_V=NSK*SLOTB, LDS_WS=LDS_V+NSV*SLOTB, LDS_OST=LDS_WS+NW*64*4, LDS_BYTES=LDS_OST+NW*4096; }
__device__ __forceinline__ void attn_unit_fx(int b,int h,int qb,const bf16*Q,const bf16*K,const bf16*V,bf16*O,float*SSQ,char*shm,const int tid,const float mfix){
  const int lane=tid&63,r32=lane&31,hi=lane>>5; const int wid=__builtin_amdgcn_readfirstlane(tid>>6);
  const long rowbase=(long)b*SEQ; const int q0=qb*QB;
  const bf16*Qw=Q+(rowbase+q0+wid*QBLK)*QP+h*D;
  const bf16*Kh=K+rowbase*KP+(h>>2)*D,*Vh=V+rowbase*VP+(h>>2)*D;
  const unsigned lds0=(unsigned)(uintptr_t)shm;
  float*wsf=(float*)(shm+fx::LDS_WS)+wid*64;
  const bf16*ksrc=Kh+(long)lane*KP+wid*8;
  const bf16*vsrc=Vh+(long)(16*(wid&3)+(lane>>2))*VP+(wid>>2)*32+(lane&3)*8;
  const unsigned kdst=lds0+fx::LDS_K+wid*1024, vdst=lds0+fx::LDS_V+wid*1024;
  #define DMA_K(t,slot) glds16(ksrc+(long)(t)*KVBLK*KP,(unsigned)__builtin_amdgcn_readfirstlane(kdst+(slot)))
  #define DMA_V(t,slot) glds16(vsrc+(long)(t)*KVBLK*VP,(unsigned)__builtin_amdgcn_readfirstlane(vdst+(slot)))
  const int vb0=(int)(lds0+fx::LDS_V)+((lane>>4)&1)*32+(lane&3)*8+(4*hi+((lane&15)>>2))*64;
  const char*Kbase=shm+fx::LDS_K; bf16x8 kf[8];
  const lds_cptr shm3=(lds_cptr)shm; const lds_cptr kp0=shm3+fx::LDS_K+hi*1024+r32*16; const lds_cptr vp0=shm3+fx::LDS_V+((lane>>4)&1)*32+(lane&3)*8+(4*hi+((lane&15)>>2))*64;
  constexpr int NT=SEQ/KVBLK;
  DMA_K(0,0);DMA_V(0,0);DMA_K(1,SLOTB);
  bf16x8 qr[4];
  #pragma unroll
  for(int d0=0;d0<4;++d0)qr[d0]=*reinterpret_cast<const bf16x8*>(&Qw[(long)r32*QP+d0*16+hi*8]);
  float l_reg=0.f;f32x16 o[2];o[0]=f32x16{};o[1]=f32x16{};
  const f32x16 negm=f32x16{};
  f32x16 pA0,pA1,pB0,pB1;
  DMA_K(2,2*SLOTB);
  WAIT_BAR(3);
  qkt(pA0,pA1,Kbase,qr,negm,r32,hi);asm volatile("s_nop 15\n\ts_nop 7":"+v"(pA0),"+v"(pA1));
  _Pragma("unroll") for(int r=0;r<16;++r)pA0[r]=__builtin_amdgcn_exp2f(pA0[r]);
  _Pragma("unroll") for(int r=0;r<16;++r)pA1[r]=__builtin_amdgcn_exp2f(pA1[r]);
  WAIT_BAR(0);
  DMA_K(3,3*SLOTB);DMA_V(1,SLOTB);
  kload8(kf,kp0+SLOTB);
  s16x4 vlo[8],vhi[8]; u32x4 pw0,pw1,pw2,pw3;
  #define PKW(P,B) cvtpk_s(P[B],P[B+1])
  #define PAF(k) __builtin_bit_cast(bf16x8,pw##k)
  #define VFR(i) (bf16x8){vlo[i][0],vlo[i][1],vlo[i][2],vlo[i][3],vhi[i][0],vhi[i][1],vhi[i][2],vhi[i][3]}
  #define PIN(x) asm volatile("":"+v"(x))
  #define GAPA(MF,A0,A1,A2,A3,W0,W1,PW) do{ MF; sacc+=A0; sacc+=A1; sacc+=A2; sacc+=A3; PIN(sacc); W0; W1; PIN(PW); SBAR(); }while(0)
  #define EX(v) __builtin_amdgcn_exp2f(v)
  #define GAPB(MF,X,B) do{ MF; X[B]=EX(X[B]); X[B+1]=EX(X[B+1]); X[B+2]=EX(X[B+2]); X[B+3]=EX(X[B+3]); PIN(X); SBAR(); }while(0)
  #define VRD(i) do{ vlo[i]=vtr(vp_+(((i)>>2)*4096+((i)&3)*1024)); vhi[i]=vtr(vp_+(((i)>>2)*4096+((i)&3)*1024+512)); }while(0)
  #define KRD(G,j,KS) do{ if(G){ kload2(kf,kp0+(KS),j); SBAR(); } }while(0)
  #define PHA(C0,C1,P0,P1,VS) do{ SBAR(); \
    const lds_cptr vp_=vp0+(VS); \
    VRD(0); SBAR(); float sacc=(P0[0]+P0[1]); \
    GAPA(C0=__builtin_amdgcn_mfma_f32_32x32x16_bf16(kf[0],qr[0],negm,0,0,0), P0[2],P0[3],P0[4],P0[5],     pw0[0]=PKW(P0,0), pw0[1]=PKW(P0,2), pw0); \
    VRD(4); SBAR(); GAPA(C1=__builtin_amdgcn_mfma_f32_32x32x16_bf16(kf[1],qr[0],negm,0,0,0), P0[6],P0[7],P0[8],P0[9],     pw0[2]=PKW(P0,4), pw0[3]=PKW(P0,6), pw0); \
    VRD(1); SBAR(); GAPA(C0=__builtin_amdgcn_mfma_f32_32x32x16_bf16(kf[2],qr[1],C0,0,0,0),   P0[10],P0[11],P0[12],P0[13], pw1[0]=PKW(P0,8), pw1[1]=PKW(P0,10), pw1); \
    VRD(5); SBAR(); GAPA(C1=__builtin_amdgcn_mfma_f32_32x32x16_bf16(kf[3],qr[1],C1,0,0,0),   P0[14],P0[15],P1[0],P1[1],   pw1[2]=PKW(P0,12),pw1[3]=PKW(P0,14), pw1); \
    VRD(2); SBAR(); GAPA(C0=__builtin_amdgcn_mfma_f32_32x32x16_bf16(kf[4],qr[2],C0,0,0,0),   P1[2],P1[3],P1[4],P1[5],     pw2[0]=PKW(P1,0), pw2[1]=PKW(P1,2), pw2); \
    VRD(6); SBAR(); GAPA(C1=__builtin_amdgcn_mfma_f32_32x32x16_bf16(kf[5],qr[2],C1,0,0,0),   P1[6],P1[7],P1[8],P1[9],     pw2[2]=PKW(P1,4), pw2[3]=PKW(P1,6), pw2); \
    VRD(3); SBAR(); GAPA(C0=__builtin_amdgcn_mfma_f32_32x32x16_bf16(kf[6],qr[3],C0,0,0,0),   P1[10],P1[11],P1[12],P1[13], pw3[0]=PKW(P1,8), pw3[1]=PKW(P1,10), pw3); \
    VRD(7); SBAR(); GAPA(C1=__builtin_amdgcn_mfma_f32_32x32x16_bf16(kf[7],qr[3],C1,0,0,0),   P1[14],P1[15],0.f,0.f,       pw3[2]=PKW(P1,12),pw3[3]=PKW(P1,14), pw3); \
    l_reg+=sacc; SBAR(); }while(0)
  #define PHB(C0,C1,KS,GL) do{ SBAR(); \
    GAPB(o[0]=__builtin_amdgcn_mfma_f32_32x32x16_bf16(PAF(0),VFR(0),o[0],0,0,0), C0,0); \
    GAPB(o[1]=__builtin_amdgcn_mfma_f32_32x32x16_bf16(PAF(0),VFR(4),o[1],0,0,0), C0,4); \
    KRD(GL,0,KS); GAPB(o[0]=__builtin_amdgcn_mfma_f32_32x32x16_bf16(PAF(1),VFR(1),o[0],0,0,0), C0,8); \
    KRD(GL,1,KS); GAPB(o[1]=__builtin_amdgcn_mfma_f32_32x32x16_bf16(PAF(1),VFR(5),o[1],0,0,0), C0,12); \
    KRD(GL,2,KS); GAPB(o[0]=__builtin_amdgcn_mfma_f32_32x32x16_bf16(PAF(2),VFR(2),o[0],0,0,0), C1,0); \
    KRD(GL,3,KS); GAPB(o[1]=__builtin_amdgcn_mfma_f32_32x32x16_bf16(PAF(2),VFR(6),o[1],0,0,0), C1,4); \
    GAPB(o[0]=__builtin_amdgcn_mfma_f32_32x32x16_bf16(PAF(3),VFR(3),o[0],0,0,0), C1,8); \
    GAPB(o[1]=__builtin_amdgcn_mfma_f32_32x32x16_bf16(PAF(3),VFR(7),o[1],0,0,0), C1,12); \
    }while(0)
  #define DMAS(t,GK,GV) do{ if(GK){DMA_K((t)+3,kd);} if(GV){DMA_V((t)+1,vd);} }while(0)
  #define ENDW(t) do{ if((t)+3<NT){WAIT_BAR(2);} else if((t)+1<NT){WAIT_BAR(1);} else {WAIT_BAR(0);} }while(0)
  #define ROTS() do{ kn=(kn+SLOTB)&(fx::NSK*SLOTB-1); kd=(kd+SLOTB)&(fx::NSK*SLOTB-1); vp=(vp==2*SLOTB)?0:vp+SLOTB; vd=(vd==2*SLOTB)?0:vd+SLOTB; }while(0)
  int vlast;
  if(wid<4){
    int kn=2*SLOTB,kd=0,vp=0,vd=2*SLOTB;
    int t=1;
    for(;t+5<NT;t+=2){
      PHA(pB0,pB1,pA0,pA1,vp); DMAS(t,true,true);   PHB(pB0,pB1,kn,true); WAIT_BAR(2); ROTS();
      PHA(pA0,pA1,pB0,pB1,vp); DMAS(t+1,true,true); PHB(pA0,pA1,kn,true); WAIT_BAR(2); ROTS();
    }
    for(;t+1<NT;t+=2){
      PHA(pB0,pB1,pA0,pA1,vp); DMAS(t,(t+3<NT),(t+1<NT));   PHB(pB0,pB1,kn,(t+1<NT)); ENDW(t);   ROTS();
      PHA(pA0,pA1,pB0,pB1,vp); DMAS(t+1,(t+4<NT),(t+2<NT)); PHB(pA0,pA1,kn,(t+2<NT)); ENDW(t+1); ROTS();
    }
    PHA(pB0,pB1,pA0,pA1,vp); PHB(pB0,pB1,kn,false); WAIT_BAR(0); ROTS();
    vlast=vp;
  } else {
    int kn=2*SLOTB,kd=0,vp=0,vd=2*SLOTB;
    PHA(pB0,pB1,pA0,pA1,vp); DMAS(1,true,true); WAIT_BAR(2);
    kd=SLOTB; vp=SLOTB; vd=0;
    int t=2;
    for(;t+5<NT;t+=2){
      PHB(pB0,pB1,kn,true); DMAS(t,true,true);   PHA(pA0,pA1,pB0,pB1,vp); WAIT_BAR(2); ROTS();
      PHB(pA0,pA1,kn,true); DMAS(t+1,true,true); PHA(pB0,pB1,pA0,pA1,vp); WAIT_BAR(2); ROTS();
    }
    for(;t+1<NT;t+=2){
      PHB(pB0,pB1,kn,true); DMAS(t,(t+3<NT),(t+1<NT));   PHA(pA0,pA1,pB0,pB1,vp); ENDW(t);   ROTS();
      PHB(pA0,pA1,kn,true); DMAS(t+1,(t+4<NT),(t+2<NT)); PHA(pB0,pB1,pA0,pA1,vp); ENDW(t+1); ROTS();
    }
    PHB(pB0,pB1,kn,false);
    vlast=vp;
  }
  { float sacc=pB0[0]+pB0[1]; _Pragma("unroll") for(int r=2;r<16;++r)sacc+=pB0[r]; _Pragma("unroll") for(int r=0;r<16;++r)sacc+=pB1[r]; l_reg+=sacc;
    pw0=(u32x4){PKW(pB0,0),PKW(pB0,2),PKW(pB0,4),PKW(pB0,6)};pw1=(u32x4){PKW(pB0,8),PKW(pB0,10),PKW(pB0,12),PKW(pB0,14)};pw2=(u32x4){PKW(pB1,0),PKW(pB1,2),PKW(pB1,4),PKW(pB1,6)};pw3=(u32x4){PKW(pB1,8),PKW(pB1,10),PKW(pB1,12),PKW(pB1,14)};
    SBAR(); pv(o,vb0+vlast,PAF(0),PAF(1),PAF(2),PAF(3)); }
  #undef PKW
  #undef PAF
  #undef VFR
  #undef PIN
  #undef GAPA
  #undef GAPB
  #undef EX
  #undef VRD
  #undef KRD
  #undef PHA
  #undef PHB
  #undef DMAS
  #undef ENDW
  #undef ROTS
  {auto rr=__builtin_amdgcn_permlane32_swap(__float_as_uint(l_reg),__float_as_uint(l_reg),false,false);l_reg=__uint_as_float(rr[0])+__uint_as_float(rr[1]);}
  int lane_e=__lane_id(); asm volatile("":"+v"(lane_e));
  { const int lane=lane_e,r32=lane&31,hi=lane>>5;
  if(hi==0)wsf[32+r32]=l_reg;asm volatile("s_waitcnt lgkmcnt(0)":::"memory");
  float rli[16];
  #pragma unroll
  for(int r=0;r<16;++r)rli[r]=__builtin_amdgcn_rcpf(wsf[32+crow(r,hi)]);
  bf16*Ow=O+(rowbase+q0+wid*QBLK)*OP+h*D;
  { bf16*stg=(bf16*)(shm+fx::LDS_OST)+wid*2048;
    #pragma unroll
    for(int r=0;r<16;++r){const int orow=crow(r,hi);
      #pragma unroll
      for(int d0=0;d0<2;++d0)stg[orow*64+d0*32+r32]=(bf16)f2bf(o[d0][r]*rli[r]);}
    asm volatile("s_waitcnt lgkmcnt(0)":::"memory");
    #pragma unroll
    for(int i=0;i<4;++i){const int row=i*8+(lane>>3),ch=lane&7; const u32x4 v=*(const u32x4*)(stg+row*64+ch*8); ATTN_STORE16(Ow+(long)row*OP+ch*8,v);
      if(SSQ){ const unsigned w_[4]={v.x,v.y,v.z,v.w}; float s_=0.f;
        #pragma unroll
        for(int k=0;k<4;++k){const float a_=__uint_as_float(w_[k]<<16),b_=__uint_as_float(w_[k]&0xffff0000u);s_+=a_*a_+b_*b_;}
        s_+=__shfl_xor(s_,1);s_+=__shfl_xor(s_,2);s_+=__shfl_xor(s_,4);
        if(ch==0)SSQ[(rowbase+q0+wid*QBLK+row)*NHEAD+h]=s_; } } } }
  asm volatile("s_waitcnt lgkmcnt(0)\n\ts_barrier":::"memory");
  #undef DMA_K
  #undef DMA_V
}

#ifndef ATTN_PV_F8
#define ATTN_PV_F8 1
#endif
#ifndef ATTN_SUM_MFMA
#define ATTN_SUM_MFMA 1
#endif
namespace f8 { constexpr int VSL=4096, LDS_K=0, LDS_V=NSLOT*SLOTB, LDS_WS=LDS_V+NSLOT*VSL, LDS_OST=LDS_WS+NW*64*4, LDS_BYTES=LDS_OST+NW*4096; typedef int v8i __attribute__((ext_vector_type(8))); }
__device__ __forceinline__ void attn_unit_f8(int b,int h,int qb,const bf16*Q,const bf16*K,const unsigned char*V8T,bf16*O,float*SSQ,char*shm,const int tid,const float k2max){
  using f8::v8i;
  const int lane=tid&63,r32=lane&31,hi=lane>>5; const int wid=__builtin_amdgcn_readfirstlane(tid>>6);
  const long rowbase=(long)b*SEQ; const int q0=qb*QB;
  const bf16*Qw=Q+(rowbase+q0+wid*QBLK)*QP+h*D;
  const bf16*Kh=K+rowbase*KP+(h>>2)*D;
  const unsigned lds0=(unsigned)(uintptr_t)shm;
  float*wsf=(float*)(shm+f8::LDS_WS)+wid*64;
  const bf16*ksrc=Kh+(long)lane*KP+wid*8;
  const unsigned char*vsrc=V8T+((long)(b*2+(h>>2))*64+lane)*SEQ+(wid&3)*16;
  const unsigned kdst=lds0+f8::LDS_K+wid*1024, vdst=lds0+f8::LDS_V+(wid&3)*1024;
  const bool vw=wid<4;
  #define DMA_K(t,slot) glds16(ksrc+(long)(t)*KVBLK*KP,(unsigned)__builtin_amdgcn_readfirstlane(kdst+(slot)))
  #define DMA_V(t,slot) do{ if(vw) glds16(vsrc+(long)(t)*KVBLK,(unsigned)__builtin_amdgcn_readfirstlane(vdst+(slot))); }while(0)
  const char*Kbase=shm+f8::LDS_K; bf16x8 kf[8];
  const lds_cptr shm3=(lds_cptr)shm; const lds_cptr kp0=shm3+f8::LDS_K+hi*1024+r32*16;
  const lds_cptr vp0=shm3+f8::LDS_V+(2*hi*64+r32)*16;
  constexpr int NT=SEQ/KVBLK;
  DMA_K(0,0);DMA_V(0,0);DMA_K(1,SLOTB);
  bf16x8 qr[4];
  #pragma unroll
  for(int d0=0;d0<4;++d0)qr[d0]=*reinterpret_cast<const bf16x8*>(&Qw[(long)r32*QP+d0*16+hi*8]);
  float l_reg=0.f;f32x16 o[2];o[0]=f32x16{};o[1]=f32x16{};
  f32x16 negm;
  { float s2=0.f;
    #pragma unroll
    for(int d0=0;d0<4;++d0){ const u32x4 w=__builtin_bit_cast(u32x4,qr[d0]); const unsigned w_[4]={w.x,w.y,w.z,w.w};
      #pragma unroll
      for(int k=0;k<4;++k){ const float a=__uint_as_float(w_[k]<<16),c=__uint_as_float(w_[k]&0xffff0000u); s2+=a*a+c*c; } }
    auto rr=__builtin_amdgcn_permlane32_swap(__float_as_uint(s2),__float_as_uint(s2),false,false); s2=__uint_as_float(rr[0])+__uint_as_float(rr[1]);
    const float cr=sqrtf(s2*k2max)*1.01f+0.01f-8.f;
    #pragma unroll
    for(int r=0;r<16;++r)negm[r]=-cr;
    asm volatile("":"+v"(negm)); }
  f32x16 pA0,pA1,pB0,pB1;
  int sl_prev=0,sl_cur=0,sl_next=SLOTB, vs_prev=0,vs_cur=0,vs_next=f8::VSL;
  #define ROT() do{sl_prev=sl_cur;sl_cur=sl_next;sl_next=(sl_next==(NSLOT-1)*SLOTB)?0:sl_next+SLOTB; vs_prev=vs_cur;vs_cur=vs_next;vs_next=(vs_next==(NSLOT-1)*f8::VSL)?0:vs_next+f8::VSL;}while(0)
  #define WAIT_BAR_R(N2,N1) do{ if(vw){WAIT_BAR(N2);} else {WAIT_BAR(N1);} }while(0)
  DMA_K(2,2*SLOTB);
  WAIT_BAR(3);
  qkt(pA0,pA1,Kbase,qr,negm,r32,hi);asm volatile("s_nop 15\n\ts_nop 7":"+v"(pA0),"+v"(pA1));
  _Pragma("unroll") for(int r=0;r<16;++r)pA0[r]=__builtin_amdgcn_exp2f(pA0[r]);
  _Pragma("unroll") for(int r=0;r<16;++r)pA1[r]=__builtin_amdgcn_exp2f(pA1[r]);
  WAIT_BAR(0);
  DMA_K(3,0);DMA_V(1,f8::VSL);
  ROT();
  kload8(kf,kp0+sl_cur);
  WAIT_BAR_R(2,1);
  v8i pw; v8i vf[2];
#if ATTN_SUM_MFMA
  f32x4 lacc=(f32x4){0.f,0.f,0.f,0.f}; v8i ones8;
  { const int one_=((((lane>>4)&1)==((lane&15)>>3))?0x38383838:0); ones8=(v8i){one_,one_,one_,one_,one_,one_,one_,one_}; asm volatile("":"+v"(ones8)); }
  #define SUM8() asm volatile("v_mfma_f32_16x16x128_f8f6f4 %0, %1, %2, %0":"+v"(lacc):"v"(pw),"v"(ones8))
  #define SADD(x) do{}while(0)
#else
  #define SUM8() do{}while(0)
  #define SADD(x) sacc+=(x)
#endif
  #define PIN(x) asm volatile("":"+v"(x))
  #define EX(v) __builtin_amdgcn_exp2f(v)
  #define PK8(P,B,OLD,HI) __builtin_amdgcn_cvt_pk_fp8_f32(P[B],P[B+1],OLD,HI)
  #define VRD8(d0) do{ const u32x4 a_=*(const __attribute__((address_space(3))) u32x4*)(vp_+(d0)*512), b_=*(const __attribute__((address_space(3))) u32x4*)(vp_+(d0)*512+1024); \
      vf[d0]=(v8i){(int)a_.x,(int)a_.y,(int)a_.z,(int)a_.w,(int)b_.x,(int)b_.y,(int)b_.z,(int)b_.w}; }while(0)
  #define GAPA8(MF,A0,A1,A2,A3,W) do{ MF; SADD(A0); SADD(A1); SADD(A2); SADD(A3); PIN(sacc); W; PIN(pw); SBAR(); }while(0)
  #define GAPX(X,B) do{ X[B]=EX(X[B]); X[B+1]=EX(X[B+1]); X[B+2]=EX(X[B+2]); X[B+3]=EX(X[B+3]); PIN(X); }while(0)
  #define KRD(G,j) do{ if(G){ kload2(kf,kp0+sl_next,j); } }while(0)
  #define PVM8(d0) asm volatile("v_mfma_f32_32x32x64_f8f6f4 %0, %1, %2, %0":"+v"(o[d0]):"v"(pw),"v"(vf[d0]))
  #define STEP8(C0,C1,P0,P1,t,GK,GV,GL) do{ SBAR(); \
    const lds_cptr vp_=vp0+vs_prev; \
    VRD8(0); VRD8(1); SBAR(); float sacc=(P0[0]+P0[1]); \
    GAPA8(C0=__builtin_amdgcn_mfma_f32_32x32x16_bf16(kf[0],qr[0],negm,0,0,0), P0[2],P0[3],P0[4],P0[5],     (pw[0]=PK8(P0,0,pw[0],false),    pw[0]=PK8(P0,2,pw[0],true))); \
    GAPA8(C1=__builtin_amdgcn_mfma_f32_32x32x16_bf16(kf[1],qr[0],negm,0,0,0), P0[6],P0[7],P0[8],P0[9],     (pw[1]=PK8(P0,4,pw[1],false),    pw[1]=PK8(P0,6,pw[1],true))); \
    GAPA8(C0=__builtin_amdgcn_mfma_f32_32x32x16_bf16(kf[2],qr[1],C0,0,0,0),   P0[10],P0[11],P0[12],P0[13], (pw[2]=PK8(P0,8,pw[2],false),    pw[2]=PK8(P0,10,pw[2],true))); \
    GAPA8(C1=__builtin_amdgcn_mfma_f32_32x32x16_bf16(kf[3],qr[1],C1,0,0,0),   P0[14],P0[15],P1[0],P1[1],   (pw[3]=PK8(P0,12,pw[3],false),   pw[3]=PK8(P0,14,pw[3],true))); \
    GAPA8(C0=__builtin_amdgcn_mfma_f32_32x32x16_bf16(kf[4],qr[2],C0,0,0,0),   P1[2],P1[3],P1[4],P1[5],     (pw[4]=PK8(P1,0,pw[4],false),    pw[4]=PK8(P1,2,pw[4],true))); \
    GAPA8(C1=__builtin_amdgcn_mfma_f32_32x32x16_bf16(kf[5],qr[2],C1,0,0,0),   P1[6],P1[7],P1[8],P1[9],     (pw[5]=PK8(P1,4,pw[5],false),    pw[5]=PK8(P1,6,pw[5],true))); \
    GAPA8(C0=__builtin_amdgcn_mfma_f32_32x32x16_bf16(kf[6],qr[3],C0,0,0,0),   P1[10],P1[11],P1[12],P1[13], (pw[6]=PK8(P1,8,pw[6],false),    pw[6]=PK8(P1,10,pw[6],true))); \
    GAPA8(C1=__builtin_amdgcn_mfma_f32_32x32x16_bf16(kf[7],qr[3],C1,0,0,0),   P1[14],P1[15],0.f,0.f,       (pw[7]=PK8(P1,12,pw[7],false),   pw[7]=PK8(P1,14,pw[7],true))); \
    l_reg+=sacc; \
    if(GK){DMA_K((t)+3,sl_cur);} if(GV){DMA_V((t)+1,vs_next);} \
    SBAR(); \
    PVM8(0); GAPX(C0,0); GAPX(C0,4); KRD(GL,0); GAPX(C0,8); KRD(GL,1); GAPX(C0,12); SBAR(); \
    PVM8(1); GAPX(C1,0); KRD(GL,2); GAPX(C1,4); KRD(GL,3); GAPX(C1,8); SUM8(); GAPX(C1,12); SBAR(); \
    }while(0)
  int t=1;
  for(;t+5<NT;t+=2){
    STEP8(pB0,pB1,pA0,pA1,t,true,true,true);     WAIT_BAR_R(2,1); ROT();
    STEP8(pA0,pA1,pB0,pB1,t+1,true,true,true);   WAIT_BAR_R(2,1); ROT();
  }
  #define ENDW(tt) do{ if((tt)+3<NT){WAIT_BAR_R(2,1);} else if((tt)+2<NT){WAIT_BAR_R(1,0);} else {WAIT_BAR(0);} }while(0)
  for(;t+1<NT;t+=2){
    STEP8(pB0,pB1,pA0,pA1,t,(t+3<NT),(t+1<NT),(t+1<NT));       ENDW(t);   ROT();
    STEP8(pA0,pA1,pB0,pB1,t+1,(t+4<NT),(t+2<NT),(t+2<NT));     ENDW(t+1); ROT();
  }
  STEP8(pB0,pB1,pA0,pA1,NT-1,false,false,false);
  { float sacc=pB0[0]+pB0[1]; _Pragma("unroll") for(int r=2;r<16;++r)sacc+=pB0[r]; _Pragma("unroll") for(int r=0;r<16;++r)sacc+=pB1[r]; l_reg+=sacc;
    _Pragma("unroll") for(int k=0;k<4;++k){ pw[k]=PK8(pB0,4*k,0,false); pw[k]=PK8(pB0,4*k+2,pw[k],true); pw[4+k]=PK8(pB1,4*k,0,false); pw[4+k]=PK8(pB1,4*k+2,pw[4+k],true); }
    const lds_cptr vp_=vp0+vs_cur; VRD8(0); VRD8(1); asm volatile("s_nop 3":"+v"(pw)); PVM8(0); PVM8(1); SUM8(); }
#if ATTN_SUM_MFMA
  asm volatile("s_nop 15\n\ts_nop 15":"+v"(lacc));
#endif
  asm volatile("s_nop 15\n\ts_nop 15":"+v"(o[0]),"+v"(o[1]));
  #undef PIN
  #undef EX
  #undef PK8
  #undef VRD8
  #undef GAPA8
  #undef GAPX
  #undef KRD
  #undef PVM8
  #undef SUM8
  #undef SADD
  #undef STEP8
  #undef ENDW
  #undef WAIT_BAR_R
  {auto rr=__builtin_amdgcn_permlane32_swap(__float_as_uint(l_reg),__float_as_uint(l_reg),false,false);l_reg=__uint_as_float(rr[0])+__uint_as_float(rr[1]);}
  int lane_e=__lane_id(); asm volatile("":"+v"(lane_e));
  { const int lane=lane_e,r32=lane&31,hi=lane>>5;
#if ATTN_SUM_MFMA
  if((lane&15)==0){ _Pragma("unroll") for(int j=0;j<4;++j)wsf[32+4*(lane>>4)+j]=lacc[j]; }
  if((lane&15)==8){ _Pragma("unroll") for(int j=0;j<4;++j)wsf[48+4*(lane>>4)+j]=lacc[j]; }
  asm volatile("s_waitcnt lgkmcnt(0)":::"memory");
#else
  if(hi==0)wsf[32+r32]=l_reg;asm volatile("s_waitcnt lgkmcnt(0)":::"memory");
#endif
  float rli[16];
  #pragma unroll
  for(int r=0;r<16;++r)rli[r]=0.125f*__builtin_amdgcn_rcpf(wsf[32+crow(r,hi)]);
  bf16*Ow=O+(rowbase+q0+wid*QBLK)*OP+h*D;
  { bf16*stg=(bf16*)(shm+f8::LDS_OST)+wid*2048;
    #pragma unroll
    for(int r=0;r<16;++r){const int orow=crow(r,hi);
      #pragma unroll
      for(int d0=0;d0<2;++d0)stg[orow*64+d0*32+r32]=(bf16)f2bf(o[d0][r]*rli[r]);}
    asm volatile("s_waitcnt lgkmcnt(0)":::"memory");
    #pragma unroll
    for(int i=0;i<4;++i){const int row=i*8+(lane>>3),ch=lane&7; const u32x4 v=*(const u32x4*)(stg+row*64+ch*8); ATTN_STORE16(Ow+(long)row*OP+ch*8,v);
      if(SSQ){ const unsigned w_[4]={v.x,v.y,v.z,v.w}; float s_=0.f;
        #pragma unroll
        for(int k=0;k<4;++k){const float a_=__uint_as_float(w_[k]<<16),b_=__uint_as_float(w_[k]&0xffff0000u);s_+=a_*a_+b_*b_;}
        s_+=__shfl_xor(s_,1);s_+=__shfl_xor(s_,2);s_+=__shfl_xor(s_,4);
        if(ch==0)SSQ[(rowbase+q0+wid*QBLK+row)*NHEAD+h]=s_; } } } }
  asm volatile("s_waitcnt lgkmcnt(0)\n\ts_barrier":::"memory");
  #undef DMA_K
  #undef DMA_V
  #undef ROT
}

#ifndef ATTN_QK_F8
#define ATTN_QK_F8 1
#endif
namespace f8q { constexpr int TSL=4096, LDS_K=0, LDS_V=NSLOT*TSL, LDS_WS=LDS_V+NSLOT*TSL, LDS_OST=LDS_WS+NW*64*4, LDS_BYTES=LDS_OST+NW*4096; }
__device__ __forceinline__ void attn_unit_f8q(int b,int h,int qb,const bf16*Q,const unsigned char*K8,const unsigned char*V8T,bf16*O,float*SSQ,char*shm,const int tid,const float k2max){
  using f8::v8i;
  const int lane=tid&63,r32=lane&31,hi=lane>>5; const int wid=__builtin_amdgcn_readfirstlane(tid>>6);
  const long rowbase=(long)b*SEQ; const int q0=qb*QB;
  const bf16*Qw=Q+(rowbase+q0+wid*QBLK)*QP+h*D;
  const unsigned lds0=(unsigned)(uintptr_t)shm;
  float*wsf=(float*)(shm+f8q::LDS_WS)+wid*64;
  const bool vw=wid<4;
  const unsigned char*dsrc=vw? V8T+((long)(b*2+(h>>2))*64+lane)*SEQ+wid*16 : K8+(((long)(b*2+(h>>2))*SEQ)+lane)*64+(wid-4)*16;
  const long dstep=vw?KVBLK:(long)KVBLK*64;
  const unsigned ddst=lds0+(vw?f8q::LDS_V:f8q::LDS_K)+(wid&3)*1024;
  const int toff=vw?1:3;
  #define DMA_T(t,slot) glds16(dsrc+(long)(t)*dstep,(unsigned)__builtin_amdgcn_readfirstlane(ddst+(slot)))
  const lds_cptr shm3=(lds_cptr)shm;
  const lds_cptr kp0=shm3+f8q::LDS_K+(2*hi*64+r32)*16;
  const lds_cptr vp0=shm3+f8q::LDS_V+(2*hi*64+r32)*16;
  constexpr int NT=SEQ/KVBLK;
  if(vw){ DMA_T(0,0); } else { DMA_T(0,0); DMA_T(1,f8q::TSL); }
  bf16x8 qr[4];
  #pragma unroll
  for(int d0=0;d0<4;++d0)qr[d0]=*reinterpret_cast<const bf16x8*>(&Qw[(long)r32*QP+d0*16+hi*8]);
  if(!vw){ DMA_T(2,2*f8q::TSL); }
  f32x16 o[2];o[0]=f32x16{};o[1]=f32x16{};
  f32x16 negm; v8i q8;
  { float s2=0.f; float qv[32];
    #pragma unroll
    for(int d0=0;d0<4;++d0){ const u32x4 w=__builtin_bit_cast(u32x4,qr[d0]); const unsigned w_[4]={w.x,w.y,w.z,w.w};
      #pragma unroll
      for(int k=0;k<4;++k){ const float a=__uint_as_float(w_[k]<<16),c=__uint_as_float(w_[k]&0xffff0000u); s2+=a*a+c*c; qv[8*d0+2*k]=4.f*a; qv[8*d0+2*k+1]=4.f*c; } }
    #pragma unroll
    for(int k=0;k<8;++k){ int w=__builtin_amdgcn_cvt_pk_fp8_f32(qv[4*k],qv[4*k+1], UNDEF32(), false); w=__builtin_amdgcn_cvt_pk_fp8_f32(qv[4*k+2],qv[4*k+3],w,true); q8[k]=w; }
    auto rr=__builtin_amdgcn_permlane32_swap(__float_as_uint(s2),__float_as_uint(s2),false,false); s2=__uint_as_float(rr[0])+__uint_as_float(rr[1]);
    const float cr=sqrtf(s2*k2max)*1.07f+0.01f-8.f;
    #pragma unroll
    for(int r=0;r<16;++r)negm[r]=-cr;
    asm volatile("":"+v"(negm),"+v"(q8)); }
  f32x16 pA0,pA1,pB0,pB1;
  int ks_cur=0,ks_next=f8q::TSL, vs_prev=0,vs_cur=0,vs_next=f8q::TSL;
  #define ROT() do{ ks_cur=ks_next;ks_next=(ks_next==(NSLOT-1)*f8q::TSL)?0:ks_next+f8q::TSL; vs_prev=vs_cur;vs_cur=vs_next;vs_next=(vs_next==(NSLOT-1)*f8q::TSL)?0:vs_next+f8q::TSL;}while(0)
  v8i kf[2]; v8i pw; v8i vf[2];
  #define RD8(dst,base,blk) do{ const u32x4 a_=*(const __attribute__((address_space(3))) u32x4*)((base)+(blk)*512), b_=*(const __attribute__((address_space(3))) u32x4*)((base)+(blk)*512+1024); \
      dst=(v8i){(int)a_.x,(int)a_.y,(int)a_.z,(int)a_.w,(int)b_.x,(int)b_.y,(int)b_.z,(int)b_.w}; }while(0)
  #define QKM(C,blk) asm volatile("v_mfma_f32_32x32x64_f8f6f4 %0, %1, %2, %3":"=&v"(C):"v"(kf[blk]),"v"(q8),"v"(negm))
  f32x4 lacc=(f32x4){0.f,0.f,0.f,0.f}; v8i ones8;
  { const int one_=((((lane>>4)&1)==((lane&15)>>3))?0x38383838:0); ones8=(v8i){one_,one_,one_,one_,one_,one_,one_,one_}; asm volatile("":"+v"(ones8)); }
  #define SUM8() asm volatile("v_mfma_f32_16x16x128_f8f6f4 %0, %1, %2, %0":"+v"(lacc):"v"(pw),"v"(ones8))
  WAIT_BAR(3);
  RD8(kf[0],kp0,0); RD8(kf[1],kp0,1);
  QKM(pA0,0); QKM(pA1,1);
  asm volatile("s_nop 15\n\ts_nop 15\n\ts_nop 15":"+v"(pA0),"+v"(pA1));
  _Pragma("unroll") for(int r=0;r<16;++r)pA0[r]=__builtin_amdgcn_exp2f(pA0[r]);
  _Pragma("unroll") for(int r=0;r<16;++r)pA1[r]=__builtin_amdgcn_exp2f(pA1[r]);
  WAIT_BAR(0);
  if(vw){ DMA_T(1,f8q::TSL); } else { DMA_T(3,0); }
  ROT();
  RD8(kf[0],kp0+ks_cur,0); RD8(kf[1],kp0+ks_cur,1);
  WAIT_BAR(1);
  #define PIN(x) asm volatile("":"+v"(x))
  #define EX(v) __builtin_amdgcn_exp2f(v)
  #define PK8(P,B,OLD,HI) __builtin_amdgcn_cvt_pk_fp8_f32(P[B],P[B+1],OLD,HI)
  #define GAPX(X,B) do{ X[B]=EX(X[B]); X[B+1]=EX(X[B+1]); X[B+2]=EX(X[B+2]); X[B+3]=EX(X[B+3]); SBAR(); }while(0)
  #define PVM8(d0) asm volatile("s_nop 1\n\tv_mfma_f32_32x32x64_f8f6f4 %0, %1, %2, %0":"+v"(o[d0]):"v"(pw),"v"(vf[d0]))
  #define STEP9(C0,C1,P0,P1,t,GK,GV,GL) do{ SBAR(); \
    const lds_cptr vp_=vp0+vs_prev; RD8(vf[0],vp_,0); RD8(vf[1],vp_,1); SBAR(); \
    QKM(C0,0); \
    pw[0]=PK8(P0,0,pw[0],false); pw[0]=PK8(P0,2,pw[0],true); pw[1]=PK8(P0,4,pw[1],false); pw[1]=PK8(P0,6,pw[1],true); \
    pw[2]=PK8(P0,8,pw[2],false); pw[2]=PK8(P0,10,pw[2],true); pw[3]=PK8(P0,12,pw[3],false); pw[3]=PK8(P0,14,pw[3],true); PIN(pw); SBAR(); \
    QKM(C1,1); \
    pw[4]=PK8(P1,0,pw[4],false); pw[4]=PK8(P1,2,pw[4],true); pw[5]=PK8(P1,4,pw[5],false); pw[5]=PK8(P1,6,pw[5],true); \
    pw[6]=PK8(P1,8,pw[6],false); pw[6]=PK8(P1,10,pw[6],true); pw[7]=PK8(P1,12,pw[7],false); pw[7]=PK8(P1,14,pw[7],true); PIN(pw); SBAR(); \
    if(vw?(GV):(GK)){ DMA_T((t)+toff,vw?vs_next:ks_cur); } \
    SBAR(); \
    PVM8(0); GAPX(C0,0); GAPX(C0,4); GAPX(C0,8); GAPX(C0,12); SBAR(); \
    if(GL){ RD8(kf[0],kp0+ks_next,0); RD8(kf[1],kp0+ks_next,1); } \
    PVM8(1); GAPX(C1,0); GAPX(C1,4); GAPX(C1,8); SUM8(); GAPX(C1,12); SBAR(); \
    }while(0)
  int t=1;
  for(;t+5<NT;t+=2){
    STEP9(pB0,pB1,pA0,pA1,t,true,true,true);     WAIT_BAR(1); ROT();
    STEP9(pA0,pA1,pB0,pB1,t+1,true,true,true);   WAIT_BAR(1); ROT();
  }
  #define ENDW(tt) do{ if((tt)+3<NT){WAIT_BAR(1);} else if((tt)+2<NT){ if(vw){WAIT_BAR(1);} else {WAIT_BAR(0);} } else {WAIT_BAR(0);} }while(0)
  for(;t+1<NT;t+=2){
    STEP9(pB0,pB1,pA0,pA1,t,(t+3<NT),(t+1<NT),(t+1<NT));       ENDW(t);   ROT();
    STEP9(pA0,pA1,pB0,pB1,t+1,(t+4<NT),(t+2<NT),(t+2<NT));     ENDW(t+1); ROT();
  }
  STEP9(pB0,pB1,pA0,pA1,NT-1,false,false,false);
  { _Pragma("unroll") for(int k=0;k<4;++k){ pw[k]=PK8(pB0,4*k,pw[k],false); pw[k]=PK8(pB0,4*k+2,pw[k],true); pw[4+k]=PK8(pB1,4*k,pw[4+k],false); pw[4+k]=PK8(pB1,4*k+2,pw[4+k],true); }
    const lds_cptr vp_=vp0+vs_cur; RD8(vf[0],vp_,0); RD8(vf[1],vp_,1); asm volatile("s_nop 3":"+v"(pw)); PVM8(0); PVM8(1); SUM8(); }
  asm volatile("s_nop 15\n\ts_nop 15":"+v"(lacc));
  asm volatile("s_nop 15\n\ts_nop 15":"+v"(o[0]),"+v"(o[1]));
  #undef PIN
  #undef EX
  #undef PK8
  #undef RD8
  #undef QKM
  #undef GAPX
  #undef PVM8
  #undef SUM8
  #undef STEP9
  #undef ENDW
  int lane_e=__lane_id(); asm volatile("":"+v"(lane_e));
  { const int lane=lane_e,r32=lane&31,hi=lane>>5;
  if((lane&15)==0){ _Pragma("unroll") for(int j=0;j<4;++j)wsf[32+4*(lane>>4)+j]=lacc[j]; }
  if((lane&15)==8){ _Pragma("unroll") for(int j=0;j<4;++j)wsf[48+4*(lane>>4)+j]=lacc[j]; }
  asm volatile("s_waitcnt lgkmcnt(0)":::"memory");
  float rli[16];
  #pragma unroll
  for(int r=0;r<16;++r)rli[r]=0.125f*__builtin_amdgcn_rcpf(wsf[32+crow(r,hi)]);
  bf16*Ow=O+(rowbase+q0+wid*QBLK)*OP+h*D;
  { bf16*stg=(bf16*)(shm+f8q::LDS_OST)+wid*2048;
    #pragma unroll
    for(int r=0;r<16;++r){const int orow=crow(r,hi);
      #pragma unroll
      for(int d0=0;d0<2;++d0)stg[orow*64+d0*32+r32]=(bf16)f2bf(o[d0][r]*rli[r]);}
    asm volatile("s_waitcnt lgkmcnt(0)":::"memory");
    #pragma unroll
    for(int i=0;i<4;++i){const int row=i*8+(lane>>3),ch=lane&7; const u32x4 v=*(const u32x4*)(stg+row*64+ch*8); ATTN_STORE16(Ow+(long)row*OP+ch*8,v);
      if(SSQ){ const unsigned w_[4]={v.x,v.y,v.z,v.w}; float s_=0.f;
        #pragma unroll
        for(int k=0;k<4;++k){const float a_=__uint_as_float(w_[k]<<16),b_=__uint_as_float(w_[k]&0xffff0000u);s_+=a_*a_+b_*b_;}
        s_+=__shfl_xor(s_,1);s_+=__shfl_xor(s_,2);s_+=__shfl_xor(s_,4);
        if(ch==0)SSQ[(rowbase+q0+wid*QBLK+row)*NHEAD+h]=s_; } } } }
  asm volatile("s_waitcnt lgkmcnt(0)\n\ts_barrier":::"memory");
  #undef DMA_T
  #undef ROT
}
constexpr int ATTN_LDS_BYTES=LDS_BYTES;
struct AttnTensors { const bf16* Q; const bf16* K; const bf16* V; bf16* O; float* SSQ; const unsigned char* V8T; const unsigned char* K8; };
struct AttnUnit { int bh; int qb; };
template<int THRL=8,int ABL=0> __device__ __forceinline__ void attn_phase(char*lds,const AttnTensors&T,const unsigned*qkmax,int grid,int block,const int tid){
  const int nunits=BATCH*NHEAD*NQB;
  const int vcu=(grid%8==0)?(block%8)*(grid/8)+block/8:block;
  const int per=(nunits+grid-1)/grid;
  float q2=0.f,k2=0.f;
  for(int i=tid;i<grid*8;i+=512){ const float2 v=*(const float2*)(qkmax+2*i); q2=fmaxf(q2,v.x); k2=fmaxf(k2,v.y); }
  #pragma unroll
  for(int o=1;o<64;o<<=1){ q2=fmaxf(q2,__shfl_xor(q2,o)); k2=fmaxf(k2,__shfl_xor(k2,o)); }
  { float*red=(float*)(lds+98304); if((tid&63)==0){ red[(tid>>6)*2]=q2; red[(tid>>6)*2+1]=k2; } __syncthreads();
    #pragma unroll
    for(int w=0;w<8;++w){ q2=fmaxf(q2,red[2*w]); k2=fmaxf(k2,red[2*w+1]); } }
  const float mfix=sqrtf(q2*k2)*1.02f+0.01f;
  const bool fixm=__builtin_amdgcn_readfirstlane(mfix<=60.f?1:0)!=0;
  const bool fixf8=__builtin_amdgcn_readfirstlane(mfix<=13.f?1:0)!=0; (void)fixf8;
  for(int i=0;i<per;++i){ const int u=vcu*per+i; if(u>=nunits)break; const int bh=u/NQB,qb=u%NQB;
    int tid_u=tid; asm volatile("":"+v"(tid_u));
#if ATTN_PV_F8 && ATTN_QK_F8
    if(fixf8) attn_unit_f8q(bh/NHEAD,bh%NHEAD,qb,T.Q,T.K8,T.V8T,T.O,T.SSQ,lds,tid_u,k2);
    else if(fixm) attn_unit<THRL,true,ABL>(bh/NHEAD,bh%NHEAD,qb,T.Q,T.K,T.V,T.O,T.SSQ,lds,tid_u,mfix);
#elif ATTN_PV_F8
    if(fixm) attn_unit_f8(bh/NHEAD,bh%NHEAD,qb,T.Q,T.K,T.V8T,T.O,T.SSQ,lds,tid_u,k2);
#else
    if(fixm) attn_unit<THRL,true,ABL>(bh/NHEAD,bh%NHEAD,qb,T.Q,T.K,T.V,T.O,T.SSQ,lds,tid_u,mfix);
#endif
    else attn_unit<THRL,false>(bh/NHEAD,bh%NHEAD,qb,T.Q,T.K,T.V,T.O,T.SSQ,lds,tid_u,0.f); }
}
#undef SBAR
#undef WAIT_BAR
}
namespace ssd {
typedef short v4i16_t __attribute__((ext_vector_type(4)));
__device__ __forceinline__ v4i16_t trr(LAS const unsigned char* p) { return __builtin_amdgcn_ds_read_tr16_b64_v4i16((LAS v4i16_t*)p); }
__device__ __forceinline__ bf16x8 cat8(v4i16_t lo, v4i16_t hi) { return (bf16x8){lo[0], lo[1], lo[2], lo[3], hi[0], hi[1], hi[2], hi[3]}; }
__device__ __forceinline__ float wave_incl_scan(float v, int lane) {
#pragma unroll
    for (int o = 1; o < 64; o <<= 1) { const float t = __shfl_up(v, o); if (lane >= o) v += t; }
    return v;
}
constexpr int BS = 272;
constexpr int XS = 144;
__device__ __forceinline__ void phase_a(LAS unsigned char* lds, const bf16_t* xbc, const float* dt, const float* a_log, bf16_t* stf, bf16_t* stb, float* decf, float* decb, int G, int bx, const int tid) {
    const int lane = tid & 63, wave = __builtin_amdgcn_readfirstlane(tid >> 6), g4 = lane >> 4, fr = lane & 15, q_ = fr >> 2, p_ = lane & 3;
    LAS unsigned char* Bimg = lds; LAS unsigned char* Ximg = lds + 34816;
    LAS float* dta = (LAS float*)(lds + 108544); LAS float* cum = (LAS float*)(lds + 110592); LAS float* tot = (LAS float*)(lds + 112640);
    constexpr int NU = BATCH * NCHUNK * 4;
    float dtv = 0.f; u32x4 Br[4], Xr[4];
#define SA_LOAD(U) do { const int bc_ = (U) >> 2, hp_ = (U) & 3, m0_ = bc_ * CHUNK; \
        dtv = dt[(size_t)(m0_ + (tid & 127)) * 16 + ((tid >> 7) & 1) * 8 + 2 * hp_ + (tid >> 8)]; \
        _Pragma("unroll") for (int i = 0; i < 4; ++i) { const int id = tid + i * 512; Br[i] = *(const u32x4*)(xbc + (size_t)(m0_ + (id >> 4)) * 1024 + 512 + (hp_ >> 1) * 128 + (id & 15) * 8); } \
        _Pragma("unroll") for (int i = 0; i < 4; ++i) { const int id = tid + i * 512, k_ = id >> 10, rid = id & 1023; Xr[i] = *(const u32x4*)(xbc + (size_t)(m0_ + (rid >> 3)) * 1024 + (2 * hp_ + k_) * 64 + (rid & 7) * 8); } } while (0)
    if (bx < NU) SA_LOAD(bx);
    for (int unit = bx; unit < NU; unit += G) {
        const int bc = unit >> 2, hp = unit & 3;
        const int qd = tid >> 7, kq = tid >> 8, dq = (tid >> 7) & 1;
        const float aq = -__expf(a_log[dq * 8 + 2 * hp + kq]);
        dta[qd * 128 + (tid & 127)] = dtv;
#pragma unroll
        for (int i = 0; i < 4; ++i) { const int id = tid + i * 512; *(LAS u32x4*)(Bimg + (id >> 4) * BS + (id & 15) * 16) = Br[i]; }
        __syncthreads();
        {
            const int s = tid & 127; const float x = dq ? dta[qd * 128 + 127 - s] : dta[qd * 128 + s];
            const float inc = wave_incl_scan(x, lane);
            if (lane == 63) tot[wave] = inc;
            __syncthreads();
            const float v = (inc + ((wave & 1) ? tot[wave - 1] : 0.f)) * aq;
            cum[qd * 128 + (dq ? 127 - s : s)] = v;
        }
        __syncthreads();
        {
#pragma unroll
            for (int i = 0; i < 4; ++i) { const int id = tid + i * 512, k = id >> 10, rid = id & 1023, row = rid >> 3, c16 = rid & 7;
                const u32x4 raw = Xr[i];
                const LAS float* cf = cum + (2 * k) * 128; const LAS float* cb_ = cum + (2 * k + 1) * 128;
                const float wf = __expf(cf[127] - cf[row]) * dta[(2 * k) * 128 + row], wb = __expf(cb_[0] - cb_[row]) * dta[(2 * k + 1) * 128 + row];
                const unsigned w[4] = {raw.x, raw.y, raw.z, raw.w}; unsigned pf[4], pb[4];
#pragma unroll
                for (int q = 0; q < 4; ++q) { const float lo = bf2f(w[q] & 0xffffu), hi = bf2f(w[q] >> 16); pf[q] = pk2(lo * wf, hi * wf); pb[q] = pk2(lo * wb, hi * wb); }
                *(LAS u32x4*)(Ximg + (2 * k) * 18432 + row * XS + c16 * 16) = (u32x4){pf[0], pf[1], pf[2], pf[3]}; *(LAS u32x4*)(Ximg + (2 * k + 1) * 18432 + row * XS + c16 * 16) = (u32x4){pb[0], pb[1], pb[2], pb[3]}; }
            if (tid < 2) { const int h = 2 * hp + tid; decf[bc * 8 + h] = __expf(cum[(2 * tid) * 128 + 127]); decb[bc * 8 + h] = __expf(cum[(2 * tid + 1) * 128]); }
        }
        __syncthreads();
        if (unit + G < NU) SA_LOAD(unit + G);
        const int k = wave >> 2, dir = (wave >> 1) & 1, pt0 = 2 * (wave & 1);
        LAS const unsigned char* Xd = Ximg + (2 * k + dir) * 18432;
        f32x4 acc[2][8];
#pragma unroll
        for (int t = 0; t < 2; ++t)
#pragma unroll
            for (int c = 0; c < 8; ++c) acc[t][c] = (f32x4){0.f, 0.f, 0.f, 0.f};
#pragma unroll
        for (int ks = 0; ks < 4; ++ks) {
            const int r0 = 32 * ks + 8 * g4 + q_;
            bf16x8 a[2];
#pragma unroll
            for (int t = 0; t < 2; ++t) a[t] = cat8(trr(Xd + r0 * XS + (16 * (pt0 + t) + 4 * p_) * 2), trr(Xd + (r0 + 4) * XS + (16 * (pt0 + t) + 4 * p_) * 2));
#pragma unroll
            for (int c = 0; c < 8; ++c) { const bf16x8 bq = cat8(trr(Bimg + r0 * BS + (16 * c + 4 * p_) * 2), trr(Bimg + (r0 + 4) * BS + (16 * c + 4 * p_) * 2));
#pragma unroll
                for (int t = 0; t < 2; ++t) acc[t][c] = __builtin_amdgcn_mfma_f32_16x16x32_bf16(bq, a[t], acc[t][c], 0, 0, 0); }
        }
        bf16_t* o = (dir ? stb : stf) + (size_t)(bc * 8 + 2 * hp + k) * 8192;
#pragma unroll
        for (int t = 0; t < 2; ++t)
#pragma unroll
            for (int c = 0; c < 8; ++c) *(u32x2*)(o + (16 * (pt0 + t) + fr) * 128 + 16 * c + 4 * g4) = (u32x2){pk2(acc[t][c][0], acc[t][c][1]), pk2(acc[t][c][2], acc[t][c][3])};
        __syncthreads();
    }
#undef SA_LOAD
}
template <int SK = 0>
__device__ __forceinline__ void phase_b(LAS unsigned char* lds, const bf16_t* xbc, const bf16_t* proj, const float* dt, const float* a_log, const float* d_skip, const float* gain, const bf16_t* prevf, const bf16_t* prevb,
                                        bf16_t* mix, int G, int bx, const int tid) {
    const int lane = tid & 63, wave = __builtin_amdgcn_readfirstlane(tid >> 6), g4 = lane >> 4, fr = lane & 15, q_ = fr >> 2, p_ = lane & 3;
    LAS unsigned char* Bimg = lds; LAS unsigned char* Ximg = lds + 34816; LAS unsigned char* Pf = lds + 53248; LAS unsigned char* Pb = lds + 70656;
    LAS float* dtf = (LAS float*)(lds + 88064); LAS float* dtb = (LAS float*)(lds + 90112); LAS float* af = (LAS float*)(lds + 92160); LAS float* sb = (LAS float*)(lds + 94208);
    for (int unit = bx; unit < BATCH * NCHUNK * SG; unit += G) {
        const int bc = unit >> 1, grp = unit & 1, m0 = bc * CHUNK;
        const int q = 16 * wave + fr;
        LAS unsigned char* Yq = (q < 64 ? lds + q * 520 : lds + 96384 + (q - 64) * 520);
        { const int hl = tid >> 7, s = tid & 127; dtf[hl * 128 + s] = dt[(size_t)(m0 + s) * 16 + 4 * grp + hl]; dtb[hl * 128 + s] = dt[(size_t)(m0 + s) * 16 + 8 + 4 * grp + hl]; }
        LAS float* gl = (LAS float*)(lds + 139264);
        if (tid < 64) *(LAS f32x4*)(gl + 4 * tid) = *(const f32x4*)(gain + grp * 256 + 4 * tid);
#pragma unroll
        for (int i = 0; i < 4; ++i) { const int id = tid + i * 512, row = id >> 4, c16 = id & 15; *(LAS u32x4*)(Bimg + row * BS + c16 * 16) = *(const u32x4*)(xbc + (size_t)(m0 + row) * 1024 + 512 + grp * 128 + c16 * 8); }
        bf16x8 Cf[4];
#pragma unroll
        for (int ks = 0; ks < 4; ++ks) Cf[ks] = *(const bf16x8*)(xbc + (size_t)(m0 + q) * 1024 + 768 + grp * 128 + 32 * ks + 8 * g4);
        __syncthreads();
        { const int hl = tid >> 7, s = tid & 127, h = 4 * grp + hl; const float aF = -__expf(a_log[h]), aB = -__expf(a_log[8 + h]);
          LAS float* tot = sb + 512;
          const float incf = wave_incl_scan(dtf[hl * 128 + s], lane), incb = wave_incl_scan(dtb[hl * 128 + 127 - s], lane);
          if (lane == 63) { tot[wave * 2] = incf; tot[wave * 2 + 1] = incb; }
          __syncthreads();
          const bool hiw = (wave & 1) != 0;
          af[hl * 128 + s] = (incf + (hiw ? tot[(wave - 1) * 2] : 0.f)) * aF;
          sb[hl * 128 + 127 - s] = (incb + (hiw ? tot[(wave - 1) * 2 + 1] : 0.f)) * aB; }
        f32x4 cb[8];
#pragma unroll
        for (int si = 0; si < 8; ++si) { cb[si] = (f32x4){0.f, 0.f, 0.f, 0.f};
#pragma unroll
            for (int ks = 0; ks < 4; ++ks) { const bf16x8 a = *(LAS const bf16x8*)(Bimg + (16 * si + fr) * BS + (32 * ks + 8 * g4) * 2); cb[si] = __builtin_amdgcn_mfma_f32_16x16x32_bf16(a, Cf[ks], cb[si], 0, 0, 0); } }
        float ss = 0.f;
        u32x4 Xr[2], Fr[2], Rr[2];
#define SB_LOAD(HL) do { const int h_ = 4 * grp + (HL); const size_t uh_ = (size_t)(bc * 8 + h_) * 8192; \
            _Pragma("unroll") for (int i = 0; i < 2; ++i) { const int id = tid + i * 512; Xr[i] = *(const u32x4*)(xbc + (size_t)(m0 + (id >> 3)) * 1024 + h_ * 64 + (id & 7) * 8); \
                Fr[i] = *(const u32x4*)(prevf + uh_ + (id >> 4) * 128 + (id & 15) * 8); Rr[i] = *(const u32x4*)(prevb + uh_ + (id >> 4) * 128 + (id & 15) * 8); } } while (0)
        SB_LOAD(0);
#pragma unroll 1
        for (int hl = 0; hl < 4; ++hl) {
            const int h = 4 * grp + hl;
            __syncthreads();
#pragma unroll
            for (int i = 0; i < 2; ++i) { const int id = tid + i * 512; *(LAS u32x4*)(Ximg + (id >> 3) * XS + (id & 7) * 16) = Xr[i];
                *(LAS u32x4*)(Pf + (id >> 4) * BS + (id & 15) * 16) = Fr[i]; *(LAS u32x4*)(Pb + (id >> 4) * BS + (id & 15) * 16) = Rr[i]; }
            __syncthreads();
            if (hl < 3) SB_LOAD(hl + 1);
            const bf16_t* zp = proj + (size_t)(m0 + q) * NPROJ_PAD + C_Z + h * 64 + 4 * g4;
            u32x2 znext = *(const u32x2*)zp;
            const float afq = af[hl * 128 + q], sbq = sb[hl * 128 + q];
            bf16x8 Mf[4];
            LAS float* Tw = (LAS float*)(lds + 135168) + wave * 128;
            float Vf = 0.f, Vb = 0.f;
            if constexpr (!(SK & 1)) {
                const float afP = wave > 0 ? af[hl * 128 + 16 * wave - 1] : 0.f, sbP = wave < 7 ? sb[hl * 128 + 16 * wave + 16] : 0.f;
#pragma unroll
                for (int k = 0; k < 2; ++k) { const int s = lane + 64 * k; float v = 0.f;
                    if (s < 16 * wave) v = dtf[hl * 128 + s] * __expf(afP - af[hl * 128 + s]);
                    else if (s >= 16 * wave + 16) v = dtb[hl * 128 + s] * __expf(sbP - sb[hl * 128 + s]);
                    Tw[s] = v; }
                if (wave > 0) Vf = __expf(afq - afP);
                if (wave < 7) Vb = __expf(sbq - sbP);
            }
#pragma unroll
            for (int i = 0; i < 4; ++i) { float mh[8];
#pragma unroll
                for (int half = 0; half < 2; ++half) { const int st = 2 * i + half;
                    if (SK & 1) {
#pragma unroll
                        for (int e = 0; e < 4; ++e) mh[half * 4 + e] = cb[2 * i + half][e];
                    } else if (st != wave) { const f32x4 t4 = *(const LAS f32x4*)(Tw + 32 * i + 16 * half + 4 * g4); const float vq = st < wave ? Vf : Vb;
#pragma unroll
                        for (int e = 0; e < 4; ++e) mh[half * 4 + e] = cb[2 * i + half][e] * (t4[e] * vq);
                    } else {
#pragma unroll
                        for (int e = 0; e < 4; ++e) { const int s = 32 * i + 16 * half + 4 * g4 + e;
                            const float wfv = dtf[hl * 128 + s] * __expf(fminf(afq - af[hl * 128 + s], 0.f)), wbv = dtb[hl * 128 + s] * __expf(fminf(sbq - sb[hl * 128 + s], 0.f));
                            const float wgt = (s <= q ? wfv : 0.f) + (s >= q ? wbv : 0.f);
                            mh[half * 4 + e] = cb[2 * i + half][e] * wgt; } } }
                u32x4 w; w.x = pk2(mh[0], mh[1]); w.y = pk2(mh[2], mh[3]); w.z = pk2(mh[4], mh[5]); w.w = pk2(mh[6], mh[7]); Mf[i] = __builtin_bit_cast(bf16x8, w); }
            const float ef = __expf(afq), eb = __expf(sbq), dsk = d_skip[h];
#pragma unroll 1
            for (int pt = 0; pt < ((SK & 2) ? 0 : 4); ++pt) {
                const u32x2 zr = znext; if (pt < 3) znext = *(const u32x2*)(zp + 16 * (pt + 1));
                f32x4 yd = (f32x4){0.f, 0.f, 0.f, 0.f}, yf = yd, yb = yd;
#pragma unroll
                for (int i = 0; i < 4; ++i) {
                    const int r0 = 32 * i + 4 * g4 + q_;
                    const bf16x8 a = cat8(trr(Ximg + r0 * XS + (16 * pt + 4 * p_) * 2), trr(Ximg + (r0 + 16) * XS + (16 * pt + 4 * p_) * 2));
                    yd = __builtin_amdgcn_mfma_f32_16x16x32_bf16(a, Mf[i], yd, 0, 0, 0); }
#pragma unroll
                for (int ks = 0; ks < 4; ++ks) {
                    const bf16x8 pa = *(LAS const bf16x8*)(Pf + (16 * pt + fr) * BS + (32 * ks + 8 * g4) * 2), pb = *(LAS const bf16x8*)(Pb + (16 * pt + fr) * BS + (32 * ks + 8 * g4) * 2);
                    yf = __builtin_amdgcn_mfma_f32_16x16x32_bf16(pa, Cf[ks], yf, 0, 0, 0); yb = __builtin_amdgcn_mfma_f32_16x16x32_bf16(pb, Cf[ks], yb, 0, 0, 0); }
                const u32x2 xr = *(LAS const u32x2*)(Ximg + q * XS + (16 * pt + 4 * g4) * 2);
                const float xq[4] = {bf2f(xr.x & 0xffffu), bf2f(xr.x >> 16), bf2f(xr.y & 0xffffu), bf2f(xr.y >> 16)};
                const float zq[4] = {bf2f(zr.x & 0xffffu), bf2f(zr.x >> 16), bf2f(zr.y & 0xffffu), bf2f(zr.y >> 16)};
                float yv[4];
#pragma unroll
                for (int j = 0; j < 4; ++j) { yv[j] = (yd[j] + ef * yf[j] + eb * yb[j] + xq[j] * dsk) * silu_f(zq[j]); ss += yv[j] * yv[j]; }
                u32x2 o; o.x = pk2(yv[0], yv[1]); o.y = pk2(yv[2], yv[3]);
                *(LAS u32x2*)(Yq + (hl * 64 + 16 * pt + 4 * g4) * 2) = o;
            }
        }
#undef SB_LOAD
        ss += __shfl_xor(ss, 16); ss += __shfl_xor(ss, 32);
        const float rstd = 1.0f / sqrtf(ss * (1.f / 256.f) + EPS);
#pragma unroll 4
        for (int i = 0; i < ((SK & 4) ? 0 : 16); ++i) { const int col = grp * 256 + i * 16 + 4 * g4; const f32x4 gn = *(const LAS f32x4*)(gl + i * 16 + 4 * g4);
            u32x2* pp = (u32x2*)(mix + (size_t)(m0 + q) * D + 512 + col); const u32x2 r = *(const LAS u32x2*)(Yq + (i * 16 + 4 * g4) * 2);
            u32x2 o; o.x = pk2(bf2f(r.x & 0xffffu) * rstd * gn.x, bf2f(r.x >> 16) * rstd * gn.y); o.y = pk2(bf2f(r.y & 0xffffu) * rstd * gn.z, bf2f(r.y >> 16) * rstd * gn.w);
            *pp = o; }
        __syncthreads();
    }
}
}
#ifndef REPEAT_PH
#define REPEAT_PH (-1)
#endif
#ifndef SSDB_IN_MEGA
#define SSDB_IN_MEGA true
#endif
constexpr int PH_PER_LAYER = 12, NPHASES = 1 + DEPTH * PH_PER_LAYER;
enum { K_RMS = 0, K_INPROJ, K_POST, K_SSDA, K_SCAN, K_MIXER, K_NORMS, K_OUTPROJ, K_ROUTER, K_GU, K_DOWN, K_COMBINE };
__global__ void __launch_bounds__(WG, 2) mega(Args args) {
    extern __shared__ __attribute__((aligned(16))) unsigned char lds_raw[];
    LAS unsigned char* lds = (LAS unsigned char*)lds_raw;
    volatile LAS unsigned* MISC = (volatile LAS unsigned*)(lds + MISC_OFF);
    {   const int tid0 = threadIdx.x;
        for (int u = tid0; u < (LDS_BYTES - LDSCTL_OFF) / 4; u += WG) ((LAS unsigned*)(lds + LDSCTL_OFF))[u] = 0u;
        __syncthreads(); }
    unsigned* barw = (unsigned*)(args.ws + WS_CTL) + CW_BAR + args.li * XCD_BAR_WORDS;
    (void)xcd_barrier_post(barw, MISC + 8);
    const int lo = args.ph_lo, hi = args.ph_hi;
    const int wave0 = __builtin_amdgcn_readfirstlane(threadIdx.x >> 6);
#define PH_BEGIN(phid) if (lo <= (phid) && (phid) < hi) { \
        int tid = wave0 * 64 + (int)__lane_id(); asm volatile("" : "+v"(tid)); int bx = blockIdx.x; asm volatile("" : "+s"(bx)); \
        const int lane = tid & 63, wave = __builtin_amdgcn_readfirstlane(tid >> 6); const int G = gridDim.x; \
        const int gw = bx * NWAVES + wave, nw = G * NWAVES, gt = bx * WG + tid, nt = G * WG; (void)lane; (void)gw; (void)nw; (void)gt; (void)nt; \
        typedef const __attribute__((address_space(4))) Args* kargp_t; kargp_t ap = (kargp_t)__builtin_amdgcn_kernarg_segment_ptr(); asm volatile("" : "+s"(ap)); \
        unsigned char* const ws = ap->ws; float* const outp = ap->out; (void)outp;
#define PH_END(phid) \
        if ((phid) + 1 < hi) { XcdBarrier b2; b2.bar = (unsigned*)(ap->ws + WS_CTL) + CW_BAR + ap->li * XCD_BAR_WORDS; b2.x = xb_xcc_id(); b2.st = MISC + 8; xcd_barrier(b2, tid); } }
#define W_(T, off) ((T*)(ws + (off)))
#define IN_(i) (ap->in[i])
    PH_BEGIN(0) if (MOE_F8) ph_convert_experts8(ap, lds + RING_OFF, bx, G, tid); ph_convert(ap, lds, gw, nw, wave, lane); ph_rope_table(W_(float, WS_ROPE), gt, nt); ph_router_table(IN_(14), IN_(13), W_(bf16_t, WS_WRH), W_(bf16_t, WS_WRL), gt, nt); if (PROJ_I8) { if (OUT_I8) ph_colmax(IN_(2), IN_(12), W_(unsigned, WS_CTL) + CW_CMAX_IN, W_(unsigned, WS_CTL) + CW_CMAX_OUT, gt, nt); else ph_quant_win_fused(IN_(2), ws + WS_WIN, W_(unsigned, WS_CTL) + CW_CMAX_IN, lds + RING_OFF, bx, G, tid); ph_rmsnorm_i8(IN_(0), IN_(1), ws + WS_HN, W_(float, WS_SA), gw, nw, lane); } PH_END(0)
#define P_RMS(l) \
    PH_BEGIN(1 + 12 * (l) + K_RMS) if ((l) == 0) { \
        if (PROJ_I8) { ph_quant_weights(IN_(2), IN_(12), ws + WS_WIN, ws + WS_WOUT, W_(unsigned, WS_CTL) + CW_CMAX_IN, W_(unsigned, WS_CTL) + CW_CMAX_OUT, lds, gw, nw, wave, lane); \
            } \
        else ph_rmsnorm(IN_(0), IN_(1) + (l) * D, W_(bf16_t, WS_HN), gw, nw, lane); } PH_END(1 + 12 * (l) + K_RMS)
#define P_INPROJ(l) \
    PH_BEGIN(1 + 12 * (l) + K_INPROJ) { if (PROJ_I8) { g8::DenseOrder S; S.init(M, NPROJ_PAD, G, bx, ws + WS_WIN + (size_t)(l) * NPROJ_PAD * D, 1); \
            g8::EpiProjI8 E{W_(bf16_t, WS_PROJ), NPROJ_PAD, W_(const float, WS_SA), W_(const unsigned, WS_CTL) + CW_CMAX_IN + (l) * NPROJ_PAD, (LAS float*)(lds + LBIAS_OFF)}; \
            g8::gemm_phase<g8::EpiProjI8, g8::DenseOrder, true, 2>(lds + RING_OFF, ws + WS_HN, S, E, tid); } \
        else { g8::DenseOrder S; S.init(M, NPROJ_PAD, G, bx, W_(const bf16_t, WS_WIN) + (size_t)(l) * NPROJ_PAD * D); g8::EpiProj E{W_(bf16_t, WS_PROJ), NPROJ_PAD}; \
            g8::gemm_phase<g8::EpiProj, g8::DenseOrder, true>(lds + RING_OFF, W_(const bf16_t, WS_HN), S, E, tid); } } PH_END(1 + 12 * (l) + K_INPROJ)
#define P_POST(l) \
    PH_BEGIN(1 + 12 * (l) + K_POST) { bf16_t* PROJ = W_(bf16_t, WS_PROJ); ph_qkrope(PROJ, IN_(3) + (l) * HD, IN_(4) + (l) * HD, W_(const float, WS_ROPE), W_(unsigned, WS_QKMAX) + 4096 * (l), ws + WS_K8, gt, nt); ph_conv(PROJ, IN_(5) + (l) * 5 * 1024, IN_(6) + (l) * 1024, W_(bf16_t, WS_XBC), gt, nt); \
        ph_dt(PROJ, IN_(7) + (l) * 16, W_(float, WS_DT), gt, nt); ph_v8t(PROJ, ws + WS_V8T, gw, nw, lane); } PH_END(1 + 12 * (l) + K_POST)
#define P_SSDA(l) \
    PH_BEGIN(1 + 12 * (l) + K_SSDA) { float* DECF = W_(float, WS_DEC); ssd::phase_a(lds + RING_OFF, W_(const bf16_t, WS_XBC), W_(const float, WS_DT), IN_(8) + (l) * 16, W_(bf16_t, WS_STF), W_(bf16_t, WS_STB), DECF, DECF + 1024, G, bx, tid); } PH_END(1 + 12 * (l) + K_SSDA)
#define P_SCAN(l) \
    PH_BEGIN(1 + 12 * (l) + K_SCAN) { float* DECF = W_(float, WS_DEC); ph_scan(W_(const bf16_t, WS_STF), W_(const bf16_t, WS_STB), W_(bf16_t, WS_PRVF), W_(bf16_t, WS_PRVB), DECF, DECF + 1024, gt, nt); } PH_END(1 + 12 * (l) + K_SCAN)
#define P_MIXER(l) \
    PH_BEGIN(1 + 12 * (l) + K_MIXER) { \
        ssd::phase_b(lds + RING_OFF, W_(const bf16_t, WS_XBC), W_(const bf16_t, WS_PROJ), W_(const float, WS_DT), IN_(8) + (l) * 16, IN_(9) + (l) * 8, IN_(10) + (l) * 512, W_(const bf16_t, WS_PRVF), W_(const bf16_t, WS_PRVB), W_(bf16_t, WS_MIX), G, bx, tid); \
        bf16_t* PROJ = W_(bf16_t, WS_PROJ); \
        const attn_body::AttnTensors AT{(const attn_body::bf16*)(PROJ + C_Q), (const attn_body::bf16*)(PROJ + C_K), (const attn_body::bf16*)(PROJ + C_V), (attn_body::bf16*)W_(bf16_t, WS_MIX), NORM_FOLD ? W_(float, WS_SSQ) : (float*)nullptr, ws + WS_V8T, ws + WS_K8}; \
        attn_body::attn_phase<8>((char*)lds_raw + RING_OFF, AT, W_(const unsigned, WS_QKMAX) + 4096 * (l), G, bx, tid); } PH_END(1 + 12 * (l) + K_MIXER)
#if NORM_FOLD && !OUT_I8
#define P_NORMS(l)
#else
#define P_NORMS(l) \
    PH_BEGIN(1 + 12 * (l) + K_NORMS) if (OUT_I8) ph_attnnorm_i8(W_(const bf16_t, WS_MIX), IN_(11) + (l) * 512, ws + WS_MIXQ, W_(float, WS_SM), gw, nw, lane); \
        else if (!NORM_FOLD) ph_attnnorm(W_(bf16_t, WS_MIX), IN_(11) + (l) * 512, gw, nw, lane); PH_END(1 + 12 * (l) + K_NORMS)
#endif
#define P_OUTPROJ(l) \
    PH_BEGIN(1 + 12 * (l) + K_OUTPROJ) { if (OUT_I8) { g8::DenseOrder S; S.init(M, D, G, bx, ws + WS_WOUT + (size_t)(l) * D * D, 1); \
            g8::EpiResidI8 E{(l) == 0 ? IN_(0) : (const float*)outp, outp, W_(const float, WS_SM), W_(const unsigned, WS_CTL) + CW_CMAX_OUT + (l) * D, (LAS float*)(lds + LBIAS_OFF)}; \
            g8::gemm_phase<g8::EpiResidI8, g8::DenseOrder, false, 2>(lds + RING_OFF, ws + WS_MIXQ, S, E, tid); } \
        else { g8::DenseOrder S; S.init(M, D, G, bx, W_(const bf16_t, WS_WOUT) + (size_t)(l) * D * D); g8::EpiResidB<(l) == 0> E{NORM_FOLD ? W_(const float, WS_SSQ) : (const float*)nullptr, (LAS float*)(lds + LBIAS_OFF), (l) == 0 ? (const void*)IN_(0) : (const void*)(ws + WS_XR), W_(bf16_t, WS_XR)}; \
            g8::gemm_phase<g8::EpiResidB<(l) == 0>, g8::DenseOrder, false, 0, 0, NORM_FOLD != 0>(lds + RING_OFF, W_(const bf16_t, WS_MIX), S, E, tid); } } PH_END(1 + 12 * (l) + K_OUTPROJ)
#define P_ROUTER(l) \
    PH_BEGIN(1 + 12 * (l) + K_ROUTER) ph_router(W_(const bf16_t, WS_XR), IN_(13) + (l) * D, W_(const bf16_t, WS_WRH) + (size_t)(l) * NE * D, W_(const bf16_t, WS_WRL) + (size_t)(l) * NE * D, IN_(15) + (l) * NE, W_(bf16_t, WS_HN), W_(int, WS_CTL) + CW_CNT + (l) * NE, W_(int, WS_SEG), W_(int, WS_TKE), W_(float, WS_TKW), W_(int, WS_TKR), lds + RING_OFF, bx, G, tid); PH_END(1 + 12 * (l) + K_ROUTER)
#define P_GU(l) \
    PH_BEGIN(1 + 12 * (l) + K_GU) { LAS int* tab = (LAS int*)(lds + RING_BYTES + 1024); g8::expert_table(W_(int, WS_CTL) + CW_CNT + (l) * NE, tab, 8, tid); \
        g8::ExpertOrder S{tab, 8, 4, G, bx, ws + WS_WGU + (size_t)(l) * NE * 2048 * D * (MOE_F8 ? 1 : 2), (size_t)2048 * D, W_(int, WS_SEG), true, MOE_F8 ? 1 : 2, (LAS unsigned short*)(lds + GIDX_OFF)}; g8::EpiGU<MOE_F8 != 0> E{ws + WS_ACT, IN_(17) + (size_t)(l) * NE * DE, IN_(19) + (size_t)(l) * NE * DE, (LAS float*)(lds + LBIAS_OFF)}; \
        g8::gemm_phase<g8::EpiGU<MOE_F8 != 0>, g8::ExpertOrder, true, MOE_F8 != 0>(lds + RING_OFF, ws + WS_HN, S, E, tid); } PH_END(1 + 12 * (l) + K_GU)
#define P_DOWN(l) \
    PH_BEGIN(1 + 12 * (l) + K_DOWN) { LAS int* tab = (LAS int*)(lds + RING_BYTES + 1024); g8::expert_table(W_(int, WS_CTL) + CW_CNT + (l) * NE, tab, 4, tid); \
        g8::ExpertOrder S{tab, 4, 8, G, bx, ws + WS_WD + (size_t)(l) * NE * D * DE * (MOE_F8 ? 1 : 2), (size_t)D * DE, W_(int, WS_SEG), false, MOE_F8 ? 1 : 2, (LAS unsigned short*)(lds + GIDX_OFF)}; g8::EpiDown<MOE_F8 != 0> E{W_(bf16_t, WS_YS), IN_(21) + (size_t)(l) * NE * D, (LAS float*)(lds + LBIAS_OFF)}; \
        g8::gemm_phase<g8::EpiDown<MOE_F8 != 0>, g8::ExpertOrder, true, MOE_F8 != 0>(lds + RING_OFF, ws + WS_ACT, S, E, tid); } PH_END(1 + 12 * (l) + K_DOWN)
#define P_COMBINE(l) \
    PH_BEGIN(1 + 12 * (l) + K_COMBINE) ph_combine(W_(const bf16_t, WS_XR), (l) + 1 < DEPTH ? W_(bf16_t, WS_XR) : (bf16_t*)nullptr, outp, W_(bf16_t, WS_YS), W_(int, WS_CTL) + CW_CNT + (l) * NE, W_(int, WS_TKE), W_(float, WS_TKW), W_(int, WS_TKR), (LAS int*)(lds + RING_OFF), (l) + 1 < DEPTH ? IN_(1) + ((l) + 1) * D : (const float*)nullptr, W_(bf16_t, WS_HN), W_(float, WS_SA), gw, nw, lane, tid); PH_END(1 + 12 * (l) + K_COMBINE)
#ifndef RT_SKIP
#define RT_SKIP 0
#endif
#define PX_QKROPE(l) PH_BEGIN(1 + 12 * (l) + K_POST) ph_qkrope(W_(bf16_t, WS_ACT), IN_(3) + (l) * HD, IN_(4) + (l) * HD, W_(const float, WS_ROPE), W_(unsigned, WS_QKMAX) + 4096 * 2, ws + WS_ACT + 100 * MiB, gt, nt); PH_END(1 + 12 * (l) + K_POST)
#define PX_CONVDT(l) PH_BEGIN(1 + 12 * (l) + K_POST) { bf16_t* PROJ = W_(bf16_t, WS_PROJ); ph_conv(PROJ, IN_(5) + (l) * 5 * 1024, IN_(6) + (l) * 1024, W_(bf16_t, WS_XBC), gt, nt); ph_dt(PROJ, IN_(7) + (l) * 16, W_(float, WS_DT), gt, nt); } PH_END(1 + 12 * (l) + K_POST)
#define PX_NORMS(l) PH_BEGIN(1 + 12 * (l) + K_NORMS) ph_attnnorm(W_(bf16_t, WS_ACT), IN_(11) + (l) * 512, gw, nw, lane); PH_END(1 + 12 * (l) + K_NORMS)
#define PX_ROUTER(l) PH_BEGIN(1 + 12 * (l) + K_ROUTER) ph_router(W_(const bf16_t, WS_XR), IN_(13) + (l) * D, W_(const bf16_t, WS_WRH) + (size_t)(l) * NE * D, W_(const bf16_t, WS_WRL) + (size_t)(l) * NE * D, IN_(15) + (l) * NE, W_(bf16_t, WS_ACT), W_(int, WS_CTL) + CW_CNT + 128, (int*)(ws + WS_ACT + 40 * MiB), (int*)(ws + WS_ACT + 48 * MiB), (float*)(ws + WS_ACT + 50 * MiB), (int*)(ws + WS_ACT + 52 * MiB), lds + RING_OFF, bx, G, tid, RT_SKIP); PH_END(1 + 12 * (l) + K_ROUTER)
#define PX_COMBINE(l) PH_BEGIN(1 + 12 * (l) + K_COMBINE) ph_combine(W_(const bf16_t, WS_XR), (bf16_t*)nullptr, (float*)(ws + WS_ACT), W_(bf16_t, WS_YS), W_(int, WS_CTL) + CW_CNT + (l) * NE, W_(int, WS_TKE), W_(float, WS_TKW), W_(int, WS_TKR), (LAS int*)(lds + RING_OFF), (const float*)nullptr, W_(bf16_t, WS_HN), W_(float, WS_SA), gw, nw, lane, tid); PH_END(1 + 12 * (l) + K_COMBINE)
#ifndef ATTN_ABL
#define ATTN_ABL 0
#endif
#define PX_ATTN(l) PH_BEGIN(1 + 12 * (l) + K_MIXER) { bf16_t* PROJ = W_(bf16_t, WS_PROJ); \
        const attn_body::AttnTensors AT{(const attn_body::bf16*)(PROJ + C_Q), (const attn_body::bf16*)(PROJ + C_K), (const attn_body::bf16*)(PROJ + C_V), (attn_body::bf16*)W_(bf16_t, WS_ACT), (float*)(ws + WS_ACT + 64 * MiB), ws + WS_V8T, ws + WS_K8}; \
        attn_body::attn_phase<8, ATTN_ABL>((char*)lds_raw + RING_OFF, AT, W_(const unsigned, WS_QKMAX) + 4096 * (l), G, bx, tid); } PH_END(1 + 12 * (l) + K_MIXER)
#define PX_GUP(l, PRB) PH_BEGIN(1 + 12 * (l) + K_GU) { LAS int* tab = (LAS int*)(lds + RING_BYTES + 1024); g8::expert_table(W_(int, WS_CTL) + CW_CNT + (l) * NE, tab, 8, tid); \
        g8::ExpertOrder S{tab, 8, 4, G, bx, ws + WS_WGU + (size_t)(l) * NE * 2048 * D * (MOE_F8 ? 1 : 2), (size_t)2048 * D, W_(int, WS_SEG), true, MOE_F8 ? 1 : 2, (LAS unsigned short*)(lds + GIDX_OFF)}; g8::EpiGU<MOE_F8 != 0> E{ws + WS_ACT, IN_(17) + (size_t)(l) * NE * DE, IN_(19) + (size_t)(l) * NE * DE, (LAS float*)(lds + LBIAS_OFF)}; \
        g8::gemm_phase<g8::EpiGU<MOE_F8 != 0>, g8::ExpertOrder, true, MOE_F8 != 0, PRB>(lds + RING_OFF, ws + WS_HN, S, E, tid); } PH_END(1 + 12 * (l) + K_GU)
#define PX_DNP(l, PRB) PH_BEGIN(1 + 12 * (l) + K_DOWN) { LAS int* tab = (LAS int*)(lds + RING_BYTES + 1024); g8::expert_table(W_(int, WS_CTL) + CW_CNT + (l) * NE, tab, 4, tid); \
        g8::ExpertOrder S{tab, 4, 8, G, bx, ws + WS_WD + (size_t)(l) * NE * D * DE * (MOE_F8 ? 1 : 2), (size_t)D * DE, W_(int, WS_SEG), false, MOE_F8 ? 1 : 2, (LAS unsigned short*)(lds + GIDX_OFF)}; g8::EpiDown<MOE_F8 != 0> E{W_(bf16_t, WS_YS), IN_(21) + (size_t)(l) * NE * D, (LAS float*)(lds + LBIAS_OFF)}; \
        g8::gemm_phase<g8::EpiDown<MOE_F8 != 0>, g8::ExpertOrder, true, MOE_F8 != 0, PRB>(lds + RING_OFF, ws + WS_ACT, S, E, tid); } PH_END(1 + 12 * (l) + K_DOWN)
#define PX_DN2(l) PX_DNP(l, 2)
#define PX_DN14(l) PX_DNP(l, 14)
#define PX_DN3(l) PX_DNP(l, 3)
#ifndef SSDB_SK
#define SSDB_SK 0
#endif
#define PX_SSDB(l) PH_BEGIN(1 + 12 * (l) + K_MIXER) { ssd::phase_b<SSDB_SK>(lds + RING_OFF, W_(const bf16_t, WS_XBC), W_(const bf16_t, WS_PROJ), W_(const float, WS_DT), IN_(8) + (l) * 16, IN_(9) + (l) * 8, IN_(10) + (l) * 512, W_(const bf16_t, WS_PRVF), W_(const bf16_t, WS_PRVB), W_(bf16_t, WS_ACT), G, bx, tid); } PH_END(1 + 12 * (l) + K_MIXER)
#define PX_GU1(l) PX_GUP(l, 3)
#define PX_GU6(l) PX_GUP(l, 6)
#define PX_GU10(l) PX_GUP(l, 10)
#define PX_GU14(l) PX_GUP(l, 14)
#define PX_GU2(l) PX_GUP(l, 2)
#ifndef DUP_RMS
#define DUP_RMS(l)
#endif
#ifndef DUP_INPROJ
#define DUP_INPROJ(l)
#endif
#ifndef DUP_POST
#define DUP_POST(l)
#endif
#ifndef DUP_SSDA
#define DUP_SSDA(l)
#endif
#ifndef DUP_SCAN
#define DUP_SCAN(l)
#endif
#ifndef DUP_MIXER
#define DUP_MIXER(l)
#endif
#ifndef DUP_NORMS
#define DUP_NORMS(l)
#endif
#ifndef DUP_OUTPROJ
#define DUP_OUTPROJ(l)
#endif
#ifndef DUP_ROUTER
#define DUP_ROUTER(l)
#endif
#ifndef DUP_GU
#define DUP_GU(l)
#endif
#ifndef DUP_DOWN
#define DUP_DOWN(l)
#endif
#ifndef DUP_COMBINE
#define DUP_COMBINE(l)
#endif
#define DUP1_0(P) P(0)
#define DUP1_1(P)
#if PROJ_I8 && !OUT_I8
#define P_RMS0(l)
#else
#define P_RMS0(l) P_RMS(l)
#endif
#define P_RMS1(l)
#define LAYER(l) P_RMS##l(l) DUP_RMS(l) P_INPROJ(l) DUP_INPROJ(l) P_POST(l) DUP_POST(l) P_SSDA(l) DUP_SSDA(l) P_SCAN(l) DUP_SCAN(l) P_MIXER(l) DUP_MIXER(l) P_NORMS(l) DUP_NORMS(l) P_OUTPROJ(l) DUP_OUTPROJ(l) P_ROUTER(l) DUP_ROUTER(l) P_GU(l) DUP_GU(l) P_DOWN(l) DUP_DOWN(l) P_COMBINE(l) DUP_COMBINE(l)
    LAYER(0)
    LAYER(1)
}

extern "C" void kernel_launch(void* const* d_in, const int* in_sizes, int n_in, void* d_out, int out_size, void* d_ws, size_t ws_size, hipStream_t stream) {
    static int grid = 0;
    if (grid == 0) {
        if (n_in != 22 || out_size != M * D || ws_size < WS_END) { fprintf(stderr, "kernel_launch: unexpected shapes n_in %d out %d ws %zu (need %zu)\n", n_in, out_size, ws_size, (size_t)WS_END); grid = -1; return; }
        int dev = 0, cus = 0;
        if (hipGetDevice(&dev) != hipSuccess || hipDeviceGetAttribute(&cus, hipDeviceAttributeMultiprocessorCount, dev) != hipSuccess) { grid = -1; return; }
        if (hipFuncSetAttribute((const void*)mega, hipFuncAttributeMaxDynamicSharedMemorySize, LDS_BYTES) != hipSuccess) { fprintf(stderr, "kernel_launch: hipFuncSetAttribute failed\n"); grid = -1; return; }
        int per_cu = 0; (void)hipOccupancyMaxActiveBlocksPerMultiprocessor(&per_cu, (const void*)mega, WG, LDS_BYTES); (void)hipGetLastError();
        if (per_cu < 1) fprintf(stderr, "kernel_launch: occupancy query says %d blocks/CU\n", per_cu);
        grid = cus;
    }
    if (grid < 0) return;
    const float* in[22]; for (int i = 0; i < 22; ++i) in[i] = (const float*)d_in[i];
    unsigned char* ws = (unsigned char*)d_ws; float* out = (float*)d_out;
    bf16_t* Win_t = (bf16_t*)(ws + WS_WIN); bf16_t* Wout_t = (bf16_t*)(ws + WS_WOUT); bf16_t* Wgu_t = (bf16_t*)(ws + WS_WGU); bf16_t* Wd_t = (bf16_t*)(ws + WS_WD);
    bf16_t* HN = (bf16_t*)(ws + WS_HN); bf16_t* PROJ = (bf16_t*)(ws + WS_PROJ); bf16_t* XBC = (bf16_t*)(ws + WS_XBC); float* DT = (float*)(ws + WS_DT); bf16_t* MIX = (bf16_t*)(ws + WS_MIX);
    float* STF = (float*)(ws + WS_STF); float* STB = (float*)(ws + WS_STB); float* YTMP = (float*)(ws + WS_YTMP); bf16_t* ACT = (bf16_t*)(ws + WS_ACT); bf16_t* YS = (bf16_t*)(ws + WS_YS);
    int* SEG = (int*)(ws + WS_SEG); float* DECF = (float*)(ws + WS_DEC); float* DECB = DECF + 1024;
    int* CNT = (int*)(ws + WS_CTL) + CW_CNT;
    (void)hipMemsetAsync(ws + WS_CTL, 0, CTL_BYTES, stream);
    Args a{}; for (int i = 0; i < 22; ++i) a.in[i] = in[i]; a.out = out; a.ws = ws;
    int li = 0;
    auto launch = [&](int lo, int hi) { a.ph_lo = lo; a.ph_hi = hi; a.li = li++; hipLaunchKernelGGL(mega, dim3(grid), dim3(WG), LDS_BYTES, stream, a); };
    launch(0, NPHASES);
}
```
